# Optimizing an MI355X kernel written in HIP

```python
import math
import jax, jax.numpy as jnp
from jax import lax
import numpy as np

D_MODEL = 1024
BATCH = 4
SEQ = 4096
DEPTH = 1

MEM_LEN = 256
EPS = 1e-6
CONV_WIDTH = CONV_HEADS = None
CONV_K = 3
CONV_GROUPS = 8
CONV_DIM = D_MODEL
GM_HEADS = 8
GM_HEAD_DIM = D_MODEL // GM_HEADS
GM_DIM = GM_HEADS * GM_HEAD_DIM
CHUNK = 128
MIX_DIM = CONV_DIM + GM_DIM
IN_DIM = 4 * CONV_DIM + 3 * GM_DIM
X_HEADS = 4
X_HEAD_DIM = D_MODEL // X_HEADS

kernel_name = "hybrid_shortconv_gmlp_memxattn_block"


def rms_norm(x, g):
    xf = x.astype(jnp.float32)
    y = xf * lax.rsqrt(jnp.mean(xf * xf, axis=-1, keepdims=True) + EPS)
    return (y * g.astype(jnp.float32)).astype(x.dtype)


def causal_depthwise_conv(h, w):
    c = h.shape[-1]
    return lax.conv_general_dilated(
        h, w[:, None, :].astype(h.dtype), window_strides=(1,),
        padding=[(CONV_K - 1, 0)], dimension_numbers=("NWC", "WIO", "NWC"),
        feature_group_count=c)


def chunked_spatial_gating(u, v, ln_g, ln_b, ws, bs):
    b, s, _ = v.shape
    n = s // CHUNK
    vh = v.reshape(b, n, CHUNK, GM_HEADS, GM_HEAD_DIM).astype(jnp.float32)
    mu = jnp.mean(vh, axis=-1, keepdims=True)
    var = jnp.mean(jnp.square(vh - mu), axis=-1, keepdims=True)
    vn = (vh - mu) * lax.rsqrt(var + EPS)
    vn = (vn * ln_g.reshape(GM_HEADS, GM_HEAD_DIM).astype(jnp.float32)
          + ln_b.reshape(GM_HEADS, GM_HEAD_DIM).astype(jnp.float32)).astype(v.dtype)
    mask = jnp.tril(jnp.ones((CHUNK, CHUNK), dtype=bool))
    w_c = jnp.where(mask[None], ws, jnp.zeros_like(ws))
    sp = jnp.einsum("hts,bnshc->bnthc", w_c, vn) + bs.T[:, :, None]
    return u * sp.reshape(b, s, GM_DIM)


def mixer_sublayer(h, w_in, conv_w, gm_ln_g, gm_ln_b, gm_ws, gm_bs, w_out):
    proj = h @ w_in
    gb, gc, xa, za, u, v, zb = jnp.split(
        proj, np.cumsum([CONV_DIM] * 4 + [GM_DIM] * 2).tolist(), axis=-1)
    a = gb * causal_depthwise_conv(gc * xa, conv_w)
    a = a * jax.nn.silu(za)
    bo = chunked_spatial_gating(jax.nn.gelu(u), jax.nn.gelu(v),
                                gm_ln_g, gm_ln_b, gm_ws, gm_bs)
    bo = bo * jax.nn.silu(zb)
    return jnp.concatenate([a, bo], axis=-1) @ w_out


def memory_cross_attention(h, m, w_q, w_kv, w_xo):
    b, s, _ = h.shape
    q = (h @ w_q).reshape(b, s, X_HEADS, X_HEAD_DIM)
    k, vv = jnp.split(m @ w_kv, 2, axis=-1)
    k = k.reshape(b, MEM_LEN, X_HEADS, X_HEAD_DIM)
    vv = vv.reshape(b, MEM_LEN, X_HEADS, X_HEAD_DIM)
    scores = jnp.einsum("bshd,bmhd->bhsm", q, k).astype(jnp.float32)
    p = jax.nn.softmax(scores * (1.0 / math.sqrt(X_HEAD_DIM)), axis=-1).astype(vv.dtype)
    o = jnp.einsum("bhsm,bmhd->bshd", p, vv).reshape(b, s, D_MODEL)
    return o @ w_xo


def setup_inputs(seed: int = 0) -> dict:
    key = jax.random.key(seed)
    ks = jax.random.split(key, 20)
    f32 = jnp.float32
    L = DEPTH
    nrm = lambda k, shape, scale: jax.random.normal(k, shape, f32) * scale
    return {
        "x": nrm(ks[0], (BATCH, SEQ, D_MODEL), 1.0),
        "mem": nrm(ks[1], (BATCH, MEM_LEN, D_MODEL), 1.0),
        "norm_mix_g": 1.0 + nrm(ks[2], (L, D_MODEL), 0.02),
        "w_in": nrm(ks[3], (L, D_MODEL, IN_DIM), D_MODEL ** -0.5),
        "conv_w": nrm(ks[4], (L, CONV_K, CONV_DIM), CONV_K ** -0.5),
        "gm_ln_g": 1.0 + nrm(ks[5], (L, GM_DIM), 0.02),
        "gm_ln_b": nrm(ks[6], (L, GM_DIM), 0.02),
        "gm_ws": nrm(ks[7], (L, GM_HEADS, CHUNK, CHUNK), 0.5 * CHUNK ** -0.5),
        "gm_bs": 1.0 + nrm(ks[8], (L, GM_HEADS, CHUNK), 0.02),
        "w_out": nrm(ks[9], (L, MIX_DIM, D_MODEL), MIX_DIM ** -0.5),
        "norm_x_g": 1.0 + nrm(ks[10], (L, D_MODEL), 0.02),
        "norm_mem_g": 1.0 + nrm(ks[11], (L, D_MODEL), 0.02),
        "w_q": nrm(ks[12], (L, D_MODEL, D_MODEL), D_MODEL ** -0.5),
        "w_kv": nrm(ks[13], (L, D_MODEL, 2 * D_MODEL), D_MODEL ** -0.5),
        "w_xo": nrm(ks[14], (L, D_MODEL, D_MODEL), D_MODEL ** -0.5),
        "norm_final_g": 1.0 + nrm(ks[15], (D_MODEL,), 0.02),
    }


def reference(x, mem, norm_mix_g, w_in, conv_w, gm_ln_g, gm_ln_b, gm_ws, gm_bs,
              w_out, norm_x_g, norm_mem_g, w_q, w_kv, w_xo, norm_final_g):
    for l in range(DEPTH):
        h = rms_norm(x, norm_mix_g[l])
        x = x + mixer_sublayer(h, w_in[l], conv_w[l], gm_ln_g[l], gm_ln_b[l],
                               gm_ws[l], gm_bs[l], w_out[l])
        h = rms_norm(x, norm_x_g[l])
        m = rms_norm(mem, norm_mem_g[l])
        x = x + memory_cross_attention(h, m, w_q[l], w_kv[l], w_xo[l])
    return rms_norm(x, norm_final_g)
```

```cpp
#include <hip/hip_runtime.h>
#include <hip/hip_cooperative_groups.h>
#include <cstdio>
#include <cstdint>
namespace cg = cooperative_groups;
#define REP_P0 1
#define REP_P1 1
#define EXTRA_SYNCS 0
#define PROBE_P2_MASK 0
#define PROBE_EPI2 0
#define REP_P3 1
#define REP_P7 1

#define LAS __attribute__((address_space(3)))
typedef unsigned short bf16_t;
typedef short bf16x8 __attribute__((ext_vector_type(8)));
typedef float f32x4 __attribute__((ext_vector_type(4)));
typedef unsigned u32x4 __attribute__((ext_vector_type(4)));
typedef unsigned u32x2 __attribute__((ext_vector_type(2)));

constexpr int D = 1024, NB = 4, SEQ = 4096, T = NB * SEQ, MEM = 256, IN_DIM = 7168, HD = 256, NH = 4;
constexpr float EPS = 1e-6f;
constexpr float LOG2E = 1.4426950408889634f;

constexpr size_t MB = 1024 * 1024;
constexpr size_t WS_H = 0 * MB;
constexpr size_t WS_P = 32 * MB;
constexpr size_t WS_HP = 32 * MB;
constexpr size_t WS_HG = 34 * MB;
constexpr size_t WS_TP = 36 * MB;
constexpr size_t WS_G = 64 * MB;
constexpr size_t WS_GU = 96 * MB;
constexpr size_t WS_GV = 128 * MB;
constexpr size_t WS_WIN = 160 * MB;
constexpr size_t WS_WOUT = 174 * MB;
constexpr size_t WS_WQ = 178 * MB;
constexpr size_t WS_WKV = 180 * MB;
constexpr size_t WS_WXO = 184 * MB;
constexpr size_t WS_MN = 186 * MB;
constexpr size_t WS_KB = 188 * MB;
constexpr size_t WS_SS1 = 192 * MB;
constexpr size_t WS_SS2 = WS_SS1 + 65536;
constexpr size_t WS_WS = WS_SS2 + 65536;
constexpr size_t WS_BAR = WS_WS + 262144;
constexpr size_t WS_CNT = WS_BAR + 16384;
constexpr size_t WS_SUB = WS_CNT + 16384;
constexpr size_t WS_SLOT = WS_SUB + 16384;
constexpr size_t WS_RS0 = 197 * MB;
constexpr size_t WS_WP = 200 * MB;
constexpr size_t WS_VW = 208 * MB;
constexpr size_t WS_END = 216 * MB;

struct Params {
    const float *x, *mem, *norm_mix_g, *w_in, *conv_w, *gm_ln_g, *gm_ln_b, *gm_ws, *gm_bs, *w_out, *norm_x_g, *norm_mem_g, *w_q, *w_kv, *w_xo, *norm_final_g;
    float* out; unsigned char* ws;
};

typedef const __attribute__((address_space(4))) Params* KP;
__device__ __forceinline__ KP launder_kp() { KP kp = (KP)__builtin_amdgcn_kernarg_segment_ptr(); asm volatile("" : "+s"(kp)); return kp; }
__device__ __forceinline__ int launder_tid(int wv) { int w = wv; asm volatile("" : "+s"(w)); int l; asm volatile("v_mbcnt_lo_u32_b32 %0, -1, 0\n\tv_mbcnt_hi_u32_b32 %0, -1, %0" : "=v"(l)); return (w << 6) | l; }
__device__ __forceinline__ unsigned cvt_pk_bf16(float lo, float hi) { unsigned r; asm volatile("v_cvt_pk_bf16_f32 %0, %1, %2" : "=v"(r) : "v"(lo), "v"(hi)); return r; }
__device__ __forceinline__ float bf_lo(unsigned w) { return __uint_as_float(w << 16); }
__device__ __forceinline__ float bf_hi(unsigned w) { return __uint_as_float(w & 0xffff0000u); }
__device__ __forceinline__ float bf2f(bf16_t b) { return __uint_as_float(((unsigned)b) << 16); }
__device__ __forceinline__ float wave_sum(float v) {
#pragma unroll
    for (int o = 1; o < 64; o <<= 1) v += __shfl_xor(v, o);
    return v;
}
__device__ __forceinline__ float shfl_xor_l(float v, int m, int lane) { return __int_as_float(__builtin_amdgcn_ds_bpermute((lane ^ m) << 2, __float_as_int(v))); }
typedef float f32x2 __attribute__((ext_vector_type(2)));
__device__ __forceinline__ float silu_f(float z) { return z * __builtin_amdgcn_rcpf(1.0f + __builtin_amdgcn_exp2f(-z * LOG2E)); }
constexpr float GC1 = -2.0f * 0.7978845608028654f * LOG2E, GC2 = GC1 * 0.044715f;
__device__ __forceinline__ f32x2 gelu_pk(f32x2 x) {
    const f32x2 a = x * (x * x * GC2 + GC1);
    f32x2 e; e.x = __builtin_amdgcn_exp2f(a.x); e.y = __builtin_amdgcn_exp2f(a.y);
    const f32x2 d = e + 1.0f; f32x2 r; r.x = __builtin_amdgcn_rcpf(d.x); r.y = __builtin_amdgcn_rcpf(d.y);
    return x * r;
}
__device__ __forceinline__ f32x2 gelu_silu_pk(f32x2 u, f32x2 z) {
    const f32x2 a = u * (u * u * GC2 + GC1), b = z * (-LOG2E);
    f32x2 ea, eb; ea.x = __builtin_amdgcn_exp2f(a.x); ea.y = __builtin_amdgcn_exp2f(a.y); eb.x = __builtin_amdgcn_exp2f(b.x); eb.y = __builtin_amdgcn_exp2f(b.y);
    const f32x2 d = (ea + 1.0f) * (eb + 1.0f); f32x2 r; r.x = __builtin_amdgcn_rcpf(d.x); r.y = __builtin_amdgcn_rcpf(d.y);
    return (u * z) * r;
}

#define XB_TMO      128
#define XB_XCNT(j)  (256  + 64 * (j))
#define XB_XSUB(j)  (1280 + 64 * (j))
#define XB_XGEN(j)  (2304 + 64 * (j))
#define XB_TOP      3328
#define XB_TOPGEN   3392
#define XCD_BAR_WORDS 3456
#define XB_SPIN_CAP (1u << 18)
__device__ __forceinline__ unsigned xb_ld(unsigned* p)              { return __hip_atomic_load(p, __ATOMIC_RELAXED, __HIP_MEMORY_SCOPE_AGENT); }
__device__ __forceinline__ unsigned xb_add(unsigned* p, unsigned v) { return __hip_atomic_fetch_add(p, v, __ATOMIC_RELAXED, __HIP_MEMORY_SCOPE_AGENT); }
__device__ __forceinline__ unsigned xb_xcc_id() { return (unsigned)__builtin_amdgcn_s_getreg((3 << 11) | 20) & 0xFu; }
#define XB_SPIN(cond, bar) do { unsigned _sp = 0; while (cond) { __builtin_amdgcn_s_sleep(1); \
    if ((++_sp & 255u) == 0u) { if (xb_ld(&(bar)[XB_TMO])) break; if (_sp > XB_SPIN_CAP) { atomicAdd(&(bar)[XB_TMO], 1u); break; } } } } while (0)
__device__ __forceinline__ void xcd_barrier_complete(unsigned* bar, unsigned x, unsigned& nloc, unsigned& nx) {
    const unsigned G = gridDim.x * gridDim.y * gridDim.z;
    unsigned sum, cnt, mine, sp = 0u;
    for (;;) {
        sum = 0u; cnt = 0u; mine = 0u;
#pragma unroll
        for (unsigned j = 0; j < 16; ++j) { const unsigned c = xb_ld(&bar[XB_XCNT(j)]); sum += c; cnt += (c > 0u) ? 1u : 0u; mine = (j == x) ? c : mine; }
        if (sum == G) break;
        __builtin_amdgcn_s_sleep(1);
        if ((++sp & 255u) == 0u) { if (xb_ld(&bar[XB_TMO])) break; if (sp > XB_SPIN_CAP) { atomicAdd(&bar[XB_TMO], 1u); break; } }
    }
    nloc = mine > 0u ? mine : 1u; nx = cnt > 0u ? cnt : 1u;
}
__device__ __forceinline__ void xcd_barrier(volatile LAS unsigned* st, int wv) {
    asm volatile("s_waitcnt vmcnt(0)" ::: "memory");
    __syncthreads();
    if (launder_tid(wv) == 0) {
        unsigned* bar = (unsigned*)(launder_kp()->ws + WS_BAR);
        const unsigned x = xb_xcc_id();
        __builtin_amdgcn_s_waitcnt(0);
        unsigned nloc = st[0], nx = st[1];
        if (nloc == 0u) { xcd_barrier_complete(bar, x, nloc, nx); st[0] = nloc; st[1] = nx; }
        const unsigned old = xb_add(&bar[XB_XSUB(x)], 1u);
        const unsigned gen = old / nloc;
        if (old + 1u == (gen + 1u) * nloc) {
            __builtin_amdgcn_fence(__ATOMIC_RELEASE, "agent");
            asm volatile("s_waitcnt vmcnt(0)" ::: "memory");
            const unsigned og = xb_add(&bar[XB_TOP], 1u);
            const unsigned tg = og / nx;
            if (og + 1u == (tg + 1u) * nx) xb_add(&bar[XB_TOPGEN], 1u);
            else XB_SPIN(xb_ld(&bar[XB_TOPGEN]) == tg, bar);
            __builtin_amdgcn_fence(__ATOMIC_ACQUIRE, "agent");
            xb_add(&bar[XB_XGEN(x)], 1u);
            asm volatile("s_waitcnt vmcnt(0)" ::: "memory");
        } else {
            XB_SPIN(xb_ld(&bar[XB_XGEN(x)]) == gen, bar);
            __builtin_amdgcn_fence(__ATOMIC_ACQUIRE, "agent");
            asm volatile("s_waitcnt vmcnt(0)" ::: "memory");
        }
    }
    __syncthreads();
}

namespace pg8 {
constexpr int BM = 256, BK = 64, HALF = 128, HTB = HALF * BK * 2, STAGE_BYTES = 8 * HTB, NXCD = 8, WGM = 4;
__host__ __device__ __forceinline__ int lds_byte(int r, int c) { const int st = (r >> 4) * 2 + (c >> 5), rr = r & 15, cc = c & 31, ob = rr * 64 + cc * 2; return st * 1024 + (ob ^ (((ob >> 9) & 1) << 5)); }
__host__ __device__ __forceinline__ void stage_rc(int b, int& R, int& C) { const int st = b / 1024, sb = b % 1024, swz = sb ^ (((sb >> 9) & 1) << 5); R = (st >> 1) * 16 + swz / 64; C = (st & 1) * 32 + (swz % 64) / 2; }
__host__ __device__ __forceinline__ int perm32(int rho) { const int n = rho >> 4, i = rho & 15; return 8 * (i >> 2) + 4 * n + (i & 3); }

struct Unit { const char* a0; const char* a1; const char* b; int pm, pn, z; };
struct Gemm { int lda, ldb, K, nt0; };

__device__ __forceinline__ bool static_order(int nM, int nN, int G, int c, int i, int& pm, int& pn) {
    const int nwg = nM * nN; const long L = (long)i * G + c; if (L >= nwg) return false;
    int wgid = (int)L; { const int q = nwg / NXCD, r = nwg % NXCD, xcd = wgid % NXCD, off = wgid / NXCD; wgid = (xcd < r ? xcd * (q + 1) : r * (q + 1) + (xcd - r) * q) + off; }
    const int nig = WGM * nN, gid = wgid / nig, fm = gid * WGM, gsz = (nM - fm) < WGM ? (nM - fm) : WGM;
    pm = fm + ((wgid % nig) % gsz); pn = (wgid % nig) / gsz; return true;
}

template <class Epi, class Sched, bool ALIGN_EPI>
__device__ __forceinline__ void gemm_phase(LAS unsigned char* lds, const Gemm g, const Sched& S, const Epi& E, int wv) {
    const int tid = launder_tid(wv), wid = __builtin_amdgcn_readfirstlane(tid >> 6), lane = tid & 63, wr = wid >> 2, wc = wid & 3, fr = lane & 15, fq = lane >> 4;
    const int nt = g.K / BK;
    unsigned voffA[2], voffB[2];
#pragma unroll
    for (int i = 0; i < 2; ++i) { int R, C; stage_rc(tid * 16 + i * 8192, R, C); const int Rb = Epi::PERM ? ((R & ~31) + perm32(R & 31)) : R;
        voffA[i] = (unsigned)(R * g.lda + C) * 2u; voffB[i] = (unsigned)(Rb * g.ldb + C) * 2u; }
    const size_t kstep = (size_t)(BK * 2);
    const size_t hstepA = (size_t)HALF * g.lda * 2, hstepB = (size_t)HALF * g.ldb * 2;
    const unsigned ldsw = (unsigned)wid * 1024u;
    const int aoff = lds_byte(wr * 64 + fr, fq * 8), boff = lds_byte(wc * 32 + fr, fq * 8);
    const int nt0 = g.nt0;
#define PG8_AP(u, kt) (((kt) < nt0 ? (u).a0 : (u).a1) + (size_t)(kt) * kstep)
#define PG8_SA(b, h) (((b) * 2 + (h)) * HTB)
#define PG8_SB(b, h) ((4 + (b) * 2 + (h)) * HTB)
#define PG8_STAGE(bufoff, gbase, voff) do { _Pragma("unroll") for (int _i = 0; _i < 2; ++_i) \
        __builtin_amdgcn_global_load_lds((const unsigned*)((const char*)(gbase) + (voff)[_i]), (LAS unsigned*)(lds + (bufoff) + ldsw + _i * 8192), 16, 0, 0); } while (0)
#define PG8_LDA(dst, b, h) do { _Pragma("unroll") for (int m = 0; m < 4; ++m) _Pragma("unroll") for (int k = 0; k < 2; ++k) dst[m][k] = *(const LAS bf16x8*)(lds + PG8_SA(b, h) + aoff + m * 2048 + k * 1024); } while (0)
#define PG8_LDB(dst, b, h) do { _Pragma("unroll") for (int n = 0; n < 2; ++n) _Pragma("unroll") for (int k = 0; k < 2; ++k) dst[n][k] = *(const LAS bf16x8*)(lds + PG8_SB(b, h) + boff + n * 2048 + k * 1024); } while (0)
#define PG8_MMA(ai, bj, At, Bt) do { __builtin_amdgcn_s_setprio(1); _Pragma("unroll") for (int m = 0; m < 4; ++m) _Pragma("unroll") for (int n = 0; n < 2; ++n) _Pragma("unroll") for (int k = 0; k < 2; ++k) \
        acc[ai][bj][m][n] = __builtin_amdgcn_mfma_f32_16x16x32_bf16(Bt[n][k], At[m][k], acc[ai][bj][m][n], 0, 0, 0); __builtin_amdgcn_s_setprio(0); } while (0)
#define PG8_WAIT_V(n) asm volatile("s_waitcnt vmcnt(" #n ")" ::: "memory")
#define PG8_WAIT_L(n) asm volatile("s_waitcnt lgkmcnt(" #n ")" ::: "memory")
#define PG8_BAR __builtin_amdgcn_s_barrier()
#define PG8_SCHED __builtin_amdgcn_sched_barrier(0)
    Unit cur, nxt; int ui = 0;
    if (!S.next(0, cur)) return;
    f32x4 acc[2][2][4][2];
#pragma unroll
    for (int a = 0; a < 2; ++a)
#pragma unroll
        for (int b = 0; b < 2; ++b)
#pragma unroll
            for (int m = 0; m < 4; ++m)
#pragma unroll
                for (int n = 0; n < 2; ++n) acc[a][b][m][n] = (f32x4){0.f, 0.f, 0.f, 0.f};
    bf16x8 At[4][2], B0[2][2], B1[2][2];
    const char* cB = cur.b;
    {
        const char* p0 = PG8_AP(cur, 0); const char* p1 = PG8_AP(cur, 1);
        PG8_STAGE(PG8_SB(0, 0), cB, voffB); PG8_STAGE(PG8_SB(0, 1), cB + hstepB, voffB); PG8_STAGE(PG8_SA(0, 0), p0, voffA); PG8_STAGE(PG8_SA(0, 1), p0 + hstepA, voffA);
        if (wr == 1) PG8_BAR;
        PG8_WAIT_V(2); PG8_BAR;
        PG8_STAGE(PG8_SB(1, 0), cB + kstep, voffB); PG8_STAGE(PG8_SA(1, 0), p1, voffA); PG8_STAGE(PG8_SB(1, 1), cB + hstepB + kstep, voffB);
        PG8_WAIT_V(6); PG8_BAR;
    }
    for (;;) {
        const bool has_next = S.next(ui + 1, nxt);
        if (!has_next) nxt = cur;
        const char* nB = nxt.b;
        for (int t = 0; t < nt; t += 2) {
            const bool last = (t == nt - 2);
            const char* a1 = PG8_AP(cur, t + 1);
            const char* a2 = last ? PG8_AP(nxt, 0) : PG8_AP(cur, t + 2); const char* b2 = last ? nB : cB + (size_t)(t + 2) * kstep;
            const char* a3 = last ? PG8_AP(nxt, 1) : PG8_AP(cur, t + 3); const char* b3 = b2 + kstep;
            PG8_LDB(B0, 0, 0); PG8_LDB(B1, 0, 1); PG8_SCHED; PG8_LDA(At, 0, 0); PG8_STAGE(PG8_SA(1, 1), a1 + hstepA, voffA);
            PG8_WAIT_V(8); PG8_WAIT_L(0); PG8_BAR; PG8_MMA(0, 0, At, B0); PG8_MMA(0, 1, At, B1); PG8_BAR; PG8_SCHED;
            PG8_LDA(At, 0, 1); PG8_STAGE(PG8_SB(0, 0), b2, voffB); PG8_STAGE(PG8_SB(0, 1), b2 + hstepB, voffB); PG8_STAGE(PG8_SA(0, 0), a2, voffA);
            PG8_WAIT_V(8); PG8_WAIT_L(0); PG8_BAR; PG8_MMA(1, 0, At, B0); PG8_MMA(1, 1, At, B1); PG8_BAR; PG8_SCHED;
            PG8_LDB(B0, 1, 0); PG8_LDB(B1, 1, 1); PG8_SCHED; PG8_LDA(At, 1, 0); PG8_STAGE(PG8_SA(0, 1), a2 + hstepA, voffA);
            PG8_WAIT_V(8); PG8_WAIT_L(0); PG8_BAR; PG8_MMA(0, 0, At, B0); PG8_MMA(0, 1, At, B1); PG8_BAR; PG8_SCHED;
            PG8_LDA(At, 1, 1); PG8_STAGE(PG8_SB(1, 0), b3, voffB); PG8_STAGE(PG8_SB(1, 1), b3 + hstepB, voffB); PG8_STAGE(PG8_SA(1, 0), a3, voffA);
            PG8_WAIT_V(8); PG8_WAIT_L(0); PG8_BAR; PG8_MMA(1, 0, At, B0); PG8_MMA(1, 1, At, B1); PG8_BAR; PG8_SCHED;
        }
        if constexpr (ALIGN_EPI) { if (wr == 0) PG8_BAR; }
        if constexpr (!Epi::AFTER_DRAIN) { E(acc, cur, wr, wc, fr, fq); if (PROBE_EPI2 && Epi::PROBE2) { asm volatile("" ::: "memory"); E(acc, cur, wr, wc, fr, fq); } }
        if (!has_next) break;
#pragma unroll
        for (int a = 0; a < 2; ++a)
#pragma unroll
            for (int b = 0; b < 2; ++b)
#pragma unroll
                for (int m = 0; m < 4; ++m)
#pragma unroll
                    for (int n = 0; n < 2; ++n) acc[a][b][m][n] = (f32x4){0.f, 0.f, 0.f, 0.f};
        cur = nxt; cB = nB; ++ui;
        if constexpr (ALIGN_EPI) { if (wr == 1) PG8_BAR; }
    }
    PG8_WAIT_V(0);
    if constexpr (!ALIGN_EPI) { if (wr == 0) PG8_BAR; }
    PG8_BAR;
    if constexpr (Epi::AFTER_DRAIN) { E.fused(acc, cur, wr, wc, fr, fq, lds, wid, lane); }
#undef PG8_AP
#undef PG8_SA
#undef PG8_SB
#undef PG8_STAGE
#undef PG8_LDA
#undef PG8_LDB
#undef PG8_MMA
#undef PG8_WAIT_V
#undef PG8_WAIT_L
#undef PG8_BAR
#undef PG8_SCHED
}
}
using pg8::Unit; using pg8::Gemm;

struct SchedPlain {
    const char *A0, *A1, *Bt; int nM, nN, G, c, lda, ldb, nt0;
    __device__ __forceinline__ bool next(int i, Unit& u) const {
        int pm, pn; if (!pg8::static_order(nM, nN, G, c, i, pm, pn)) return false;
        u.pm = pm; u.pn = pn; u.z = 0;
        u.a0 = A0 + (size_t)pm * 256 * lda * 2; u.a1 = A1 + (size_t)pm * 256 * lda * 2 - (size_t)nt0 * 128; u.b = Bt + (size_t)pn * 256 * ldb * 2; return true;
    }
};
struct SchedOne {
    Unit u0;
    __device__ __forceinline__ bool next(int i, Unit& u) const { if (i != 0) return false; u = u0; return true; }
};

struct EpiG1 {
    static constexpr bool PERM = false, AFTER_DRAIN = false, PROBE2 = true;
    bf16_t *A, *GU, *GV; float *HP, *HG, *TP; const float* cw;
    __device__ __forceinline__ void operator()(const f32x4 (&acc)[2][2][4][2], const Unit& u, int wr, int wc, int fr, int fq) const {
        const int row0 = u.pm * 256 + wr * 64 + fr;
        if (u.pn < 16) {
            const int ch = u.pn * 64 + wc * 16 + fq * 4;
            const f32x4 w0 = *(const f32x4*)(cw + ch), w1 = *(const f32x4*)(cw + D + ch), w2 = *(const f32x4*)(cw + 2 * D + ch);
#pragma unroll
            for (int ai = 0; ai < 2; ++ai) {
                const int grp = u.pm * 4 + ai * 2 + wr;
                f32x4 pprev = (f32x4){0.f, 0.f, 0.f, 0.f};
#pragma unroll
                for (int m = 0; m < 4; ++m) {
                    const size_t off = (size_t)(row0 + ai * 128 + m * 16) * D + ch;
                    const f32x4 gb = acc[ai][0][m][0], gc = acc[ai][0][m][1], xa = acc[ai][1][m][0], za = acc[ai][1][m][1];
                    f32x4 pv, gv, av;
#pragma unroll
                    for (int j = 0; j < 4; ++j) { pv[j] = gc[j] * xa[j]; gv[j] = gb[j] * silu_f(za[j]); }
#pragma unroll
                    for (int j = 0; j < 4; ++j) {
                        const int pi = __float_as_int(pv[j]), qi = __float_as_int(pprev[j]);
                        float cv = w2[j] * pv[j];
                        cv = fmaf(__int_as_float(__builtin_amdgcn_update_dpp(0, pi, 0x111, 0xf, 0xf, true)), w1[j], cv);
                        cv = fmaf(__int_as_float(__builtin_amdgcn_update_dpp(0, pi, 0x112, 0xf, 0xf, true)), w0[j], cv);
                        if (m > 0) {
                            cv = fmaf(__int_as_float(__builtin_amdgcn_update_dpp(0, qi, 0x10f, 0xf, 0xf, true)), w1[j], cv);
                            cv = fmaf(__int_as_float(__builtin_amdgcn_update_dpp(0, qi, 0x10e, 0xf, 0xf, true)), w0[j], cv);
                        }
                        av[j] = gv[j] * cv;
                    }
                    u32x2 aw; aw.x = cvt_pk_bf16(av[0], av[1]); aw.y = cvt_pk_bf16(av[2], av[3]);
                    if (m == 0) {
                        if (fr < 2) { *(f32x4*)(HP + ((size_t)grp * 2 + fr) * D + ch) = pv; *(f32x4*)(HG + ((size_t)grp * 2 + fr) * D + ch) = gv; }
                        else *(u32x2*)(A + off) = aw;
                    } else *(u32x2*)(A + off) = aw;
                    if (m == 3 && fr >= 14) *(f32x4*)(TP + ((size_t)grp * 2 + (fr - 14)) * D + ch) = pv;
                    pprev = pv;
                }
            }
        } else if (u.pn < 24) {
            const int ch = (u.pn - 16) * 128 + wc * 32 + fq * 8;
#pragma unroll
            for (int ai = 0; ai < 2; ++ai)
#pragma unroll
                for (int m = 0; m < 4; ++m) {
                    const size_t off = (size_t)(row0 + ai * 128 + m * 16) * D + ch;
                    u32x4 w;
#pragma unroll
                    for (int n = 0; n < 2; ++n)
#pragma unroll
                        for (int j2 = 0; j2 < 2; ++j2) { const f32x2 o = gelu_silu_pk((f32x2){acc[ai][0][m][n][2 * j2], acc[ai][0][m][n][2 * j2 + 1]}, (f32x2){acc[ai][1][m][n][2 * j2], acc[ai][1][m][n][2 * j2 + 1]}); w[n * 2 + j2] = cvt_pk_bf16(o.x, o.y); }
                    *(u32x4*)(GU + off) = w;
                }
        } else {
#pragma unroll
            for (int ai = 0; ai < 2; ++ai)
#pragma unroll
                for (int m = 0; m < 4; ++m)
#pragma unroll
                    for (int bj = 0; bj < 2; ++bj) {
                        const size_t off = (size_t)(row0 + ai * 128 + m * 16) * D + (u.pn - 24) * 256 + bj * 128 + wc * 32 + fq * 8;
                        u32x4 w;
#pragma unroll
                        for (int n = 0; n < 2; ++n)
#pragma unroll
                            for (int j2 = 0; j2 < 2; ++j2) { const f32x2 o = gelu_pk((f32x2){acc[ai][bj][m][n][2 * j2], acc[ai][bj][m][n][2 * j2 + 1]}); w[n * 2 + j2] = cvt_pk_bf16(o.x, o.y); }
                        *(u32x4*)(GV + off) = w;
                    }
        }
    }
};
__device__ __forceinline__ int win_srccol(int np) {
    const int pn = np >> 8, ct = np & 255, bj = ct >> 7, wc = (ct >> 5) & 3, n = (ct >> 4) & 1, fq = (ct >> 2) & 3, j = ct & 3;
    if (pn < 16) return (2 * bj + n) * 1024 + pn * 64 + wc * 16 + fq * 4 + j;
    if (pn < 24) return (bj ? 6 : 4) * 1024 + (pn - 16) * 128 + wc * 32 + fq * 8 + n * 4 + j;
    return 5 * 1024 + (pn - 24) * 256 + bj * 128 + wc * 32 + fq * 8 + n * 4 + j;
}

struct EpiBf {
    static constexpr bool PERM = true, AFTER_DRAIN = false, PROBE2 = false;
    bf16_t* O; int ld;
    __device__ __forceinline__ void operator()(const f32x4 (&acc)[2][2][4][2], const Unit& u, int wr, int wc, int fr, int fq) const {
        const int row0 = u.pm * 256 + wr * 64 + fr, col0 = u.pn * 256 + wc * 32 + fq * 8;
#pragma unroll
        for (int ai = 0; ai < 2; ++ai)
#pragma unroll
            for (int m = 0; m < 4; ++m) { const size_t off = (size_t)(row0 + ai * 128 + m * 16) * ld + col0;
#pragma unroll
                for (int bj = 0; bj < 2; ++bj) { const f32x4 v0 = acc[ai][bj][m][0], v1 = acc[ai][bj][m][1];
                    u32x4 w; w.x = cvt_pk_bf16(v0[0], v0[1]); w.y = cvt_pk_bf16(v0[2], v0[3]); w.z = cvt_pk_bf16(v1[0], v1[1]); w.w = cvt_pk_bf16(v1[2], v1[3]); *(u32x4*)(O + off + bj * 128) = w; }
            }
    }
};
struct EpiX1 {
    static constexpr bool PERM = true, AFTER_DRAIN = false, PROBE2 = false;
    bf16_t* hb; const float* rs0; const float* g; float* rowss;
    __device__ __forceinline__ void operator()(const f32x4 (&acc)[2][2][4][2], const Unit& u, int wr, int wc, int fr, int fq) const {
        const int row0 = u.pm * 256 + wr * 64 + fr, col0 = u.pn * 256 + wc * 32 + fq * 8;
        f32x4 ig[2][2];
#pragma unroll
        for (int bj = 0; bj < 2; ++bj)
#pragma unroll
            for (int n = 0; n < 2; ++n) { const f32x4 gv = *(const f32x4*)(g + col0 + bj * 128 + 4 * n);
#pragma unroll
                for (int j = 0; j < 4; ++j) ig[bj][n][j] = __builtin_amdgcn_rcpf(gv[j]); }
#pragma unroll
        for (int ai = 0; ai < 2; ++ai)
#pragma unroll
            for (int m = 0; m < 4; ++m) {
                const int row = row0 + ai * 128 + m * 16; const size_t off = (size_t)row * D + col0; float ss = 0.f; const float irs = __builtin_amdgcn_rcpf(rs0[row]);
#pragma unroll
                for (int bj = 0; bj < 2; ++bj) { const u32x4 hw = *(const u32x4*)(hb + off + bj * 128);
                    f32x4 v0, v1; v0[0] = bf_lo(hw.x); v0[1] = bf_hi(hw.x); v0[2] = bf_lo(hw.y); v0[3] = bf_hi(hw.y); v1[0] = bf_lo(hw.z); v1[1] = bf_hi(hw.z); v1[2] = bf_lo(hw.w); v1[3] = bf_hi(hw.w);
                    v0 = v0 * irs * ig[bj][0] + acc[ai][bj][m][0]; v1 = v1 * irs * ig[bj][1] + acc[ai][bj][m][1];
                    ss += (v0[0] * v0[0] + v0[1] * v0[1]) + (v0[2] * v0[2] + v0[3] * v0[3]) + (v1[0] * v1[0] + v1[1] * v1[1]) + (v1[2] * v1[2] + v1[3] * v1[3]);
                    u32x4 w; w.x = cvt_pk_bf16(v0[0], v0[1]); w.y = cvt_pk_bf16(v0[2], v0[3]); w.z = cvt_pk_bf16(v1[0], v1[1]); w.w = cvt_pk_bf16(v1[2], v1[3]); *(u32x4*)(hb + off + bj * 128) = w;
                }
                ss += shfl_xor_l(ss, 16, fr + 16 * fq); ss += shfl_xor_l(ss, 32, fr + 16 * fq);
                if (fq == 0) unsafeAtomicAdd(rowss + row, ss);
            }
    }
};
struct EpiFinal {
    static constexpr bool PERM = true, AFTER_DRAIN = true, PROBE2 = false;
    const bf16_t* xb; float* out; const float* gf; float* slots; unsigned* cnt; unsigned* bar;
    __device__ __forceinline__ void fused(f32x4 (&acc)[2][2][4][2], const Unit& u, int wr, int wc, int fr, int fq, LAS unsigned char* lds, int wid, int lane) const {
        LAS float* red = (LAS float*)lds; LAS float* rsl = (LAS float*)(lds + 4096);
        const int tid = wid * 64 + lane, col0 = u.pn * 256 + wc * 32 + fq * 8;
#pragma unroll
        for (int ai = 0; ai < 2; ++ai)
#pragma unroll
            for (int m = 0; m < 4; ++m) { const int rl = ai * 128 + wr * 64 + m * 16 + fr; const size_t off = (size_t)(u.pm * 256 + rl) * D + col0; float ss = 0.f;
#pragma unroll
                for (int bj = 0; bj < 2; ++bj) { const u32x4 xw = *(const u32x4*)(xb + off + bj * 128);
                    f32x4 v0 = acc[ai][bj][m][0], v1 = acc[ai][bj][m][1];
                    v0[0] += bf_lo(xw.x); v0[1] += bf_hi(xw.x); v0[2] += bf_lo(xw.y); v0[3] += bf_hi(xw.y); v1[0] += bf_lo(xw.z); v1[1] += bf_hi(xw.z); v1[2] += bf_lo(xw.w); v1[3] += bf_hi(xw.w);
                    acc[ai][bj][m][0] = v0; acc[ai][bj][m][1] = v1;
                    ss += (v0[0] * v0[0] + v0[1] * v0[1]) + (v0[2] * v0[2] + v0[3] * v0[3]) + (v1[0] * v1[0] + v1[1] * v1[1]) + (v1[2] * v1[2] + v1[3] * v1[3]); }
                ss += shfl_xor_l(ss, 16, fr + 16 * fq); ss += shfl_xor_l(ss, 32, fr + 16 * fq);
                if (fq == 0) red[rl * 4 + wc] = ss; }
        __syncthreads();
        if (tid < 256) { const f32x4 v = *(const LAS f32x4*)(red + tid * 4); __hip_atomic_store(slots + (size_t)(u.pm * 4 + u.pn) * 256 + tid, (v[0] + v[1]) + (v[2] + v[3]), __ATOMIC_RELAXED, __HIP_MEMORY_SCOPE_AGENT); }
        asm volatile("s_waitcnt vmcnt(0)" ::: "memory"); __syncthreads();
        if (tid == 0) { unsigned* cw = cnt + 64 * u.pm; (void)xb_add(cw, 1u); XB_SPIN(xb_ld(cw) < 4u, bar); }
        __syncthreads();
        if (tid < 256) { const float* sp = slots + (size_t)(u.pm * 4) * 256 + tid;
            const float t = (__hip_atomic_load(sp, __ATOMIC_RELAXED, __HIP_MEMORY_SCOPE_AGENT) + __hip_atomic_load(sp + 256, __ATOMIC_RELAXED, __HIP_MEMORY_SCOPE_AGENT)) +
                            (__hip_atomic_load(sp + 512, __ATOMIC_RELAXED, __HIP_MEMORY_SCOPE_AGENT) + __hip_atomic_load(sp + 768, __ATOMIC_RELAXED, __HIP_MEMORY_SCOPE_AGENT));
            rsl[tid] = rsqrtf(t * (1.0f / D) + EPS); }
        __syncthreads();
        f32x4 g4[2][2];
#pragma unroll
        for (int bj = 0; bj < 2; ++bj) { g4[bj][0] = *(const f32x4*)(gf + col0 + bj * 128); g4[bj][1] = *(const f32x4*)(gf + col0 + bj * 128 + 4); }
#pragma unroll
        for (int ai = 0; ai < 2; ++ai)
#pragma unroll
            for (int m = 0; m < 4; ++m) { const int rl = ai * 128 + wr * 64 + m * 16 + fr; const size_t off = (size_t)(u.pm * 256 + rl) * D + col0; const float rs = rsl[rl];
#pragma unroll
                for (int bj = 0; bj < 2; ++bj) { *(f32x4*)(out + off + bj * 128) = acc[ai][bj][m][0] * rs * g4[bj][0]; *(f32x4*)(out + off + bj * 128 + 4) = acc[ai][bj][m][1] * rs * g4[bj][1]; } }
        __syncthreads();
    }
};
struct EpiS {
    static constexpr bool PERM = true, AFTER_DRAIN = true, PROBE2 = false;
    bf16_t* Pb;
    const float* rowss; int grow0, hcol;
    __device__ __forceinline__ void fused(f32x4 (&acc)[2][2][4][2], const Unit& u, int wr, int wc, int fr, int fq, LAS unsigned char* lds, int wid, int lane) const {
        LAS float* rmax = (LAS float*)lds; LAS float* rsum = (LAS float*)(lds + 4096);
#pragma unroll
        for (int ai = 0; ai < 2; ++ai)
#pragma unroll
            for (int m = 0; m < 4; ++m) { const int rl = ai * 128 + wr * 64 + m * 16 + fr; float mx = -3.0e38f;
                const float rs = rsqrtf(rowss[grow0 + rl] * (1.0f / D) + EPS) * 0.0625f;
#pragma unroll
                for (int bj = 0; bj < 2; ++bj)
#pragma unroll
                    for (int n = 0; n < 2; ++n) { acc[ai][bj][m][n] = acc[ai][bj][m][n] * rs;
#pragma unroll
                        for (int j = 0; j < 4; ++j) mx = fmaxf(mx, acc[ai][bj][m][n][j]); }
                mx = fmaxf(mx, shfl_xor_l(mx, 16, fr + 16 * fq)); mx = fmaxf(mx, shfl_xor_l(mx, 32, fr + 16 * fq));
                if (fq == 0) rmax[rl * 4 + wc] = mx; }
        __syncthreads();
#pragma unroll
        for (int ai = 0; ai < 2; ++ai)
#pragma unroll
            for (int m = 0; m < 4; ++m) { const int rl = ai * 128 + wr * 64 + m * 16 + fr; const f32x4 mv = *(const LAS f32x4*)(rmax + rl * 4);
                const float mx = fmaxf(fmaxf(mv[0], mv[1]), fmaxf(mv[2], mv[3])) * LOG2E; float sm = 0.f;
#pragma unroll
                for (int bj = 0; bj < 2; ++bj)
#pragma unroll
                    for (int n = 0; n < 2; ++n)
#pragma unroll
                        for (int j = 0; j < 4; ++j) { const float e = __builtin_amdgcn_exp2f(acc[ai][bj][m][n][j] * LOG2E - mx); acc[ai][bj][m][n][j] = e; sm += e; }
                sm += shfl_xor_l(sm, 16, fr + 16 * fq); sm += shfl_xor_l(sm, 32, fr + 16 * fq);
                if (fq == 0) rsum[rl * 4 + wc] = sm; }
        __syncthreads();
        const int col0 = wc * 32 + fq * 8;
#pragma unroll
        for (int ai = 0; ai < 2; ++ai)
#pragma unroll
            for (int m = 0; m < 4; ++m) { const int rl = ai * 128 + wr * 64 + m * 16 + fr; const f32x4 sv = *(const LAS f32x4*)(rsum + rl * 4);
                const float inv = 1.0f / ((sv[0] + sv[1]) + (sv[2] + sv[3]));
                bf16_t* dst = Pb + (size_t)(grow0 + rl) * D + hcol + col0;
#pragma unroll
                for (int bj = 0; bj < 2; ++bj) { const f32x4 v0 = acc[ai][bj][m][0] * inv, v1 = acc[ai][bj][m][1] * inv;
                    u32x4 w; w.x = cvt_pk_bf16(v0[0], v0[1]); w.y = cvt_pk_bf16(v0[2], v0[3]); w.z = cvt_pk_bf16(v1[0], v1[1]); w.w = cvt_pk_bf16(v1[2], v1[3]); *(u32x4*)(dst + bj * 128) = w; }
            }
        __syncthreads();
    }
};

template <int NR> __device__ __forceinline__ void rms_rows_to_bf16(const float* const (&xrow)[NR], const float* g, bf16_t* const (&orow)[NR], int lane, float* const (&rso)[NR]) {
    f32x4 v[NR][4];
#pragma unroll
    for (int r = 0; r < NR; ++r)
#pragma unroll
        for (int j = 0; j < 4; ++j) v[r][j] = ((const f32x4*)xrow[r] + lane)[64 * j];
    const f32x4* gr = (const f32x4*)g + lane; f32x4 gg[4];
#pragma unroll
    for (int j = 0; j < 4; ++j) gg[j] = gr[64 * j];
#pragma unroll
    for (int r = 0; r < NR; ++r) { float s = 0.f;
#pragma unroll
        for (int j = 0; j < 4; ++j) s += (v[r][j][0] * v[r][j][0] + v[r][j][1] * v[r][j][1]) + (v[r][j][2] * v[r][j][2] + v[r][j][3] * v[r][j][3]);
        const float rstd = rsqrtf(wave_sum(s) * (1.0f / D) + EPS); u32x2* o8 = (u32x2*)orow[r] + lane; if (rso[r] && lane == 0) *rso[r] = rstd;
#pragma unroll
        for (int j = 0; j < 4; ++j) { u32x2 w; w.x = cvt_pk_bf16(v[r][j][0] * rstd * gg[j][0], v[r][j][1] * rstd * gg[j][1]); w.y = cvt_pk_bf16(v[r][j][2] * rstd * gg[j][2], v[r][j][3] * rstd * gg[j][3]); o8[64 * j] = w; } }
}
struct TDesc { const float* W; bf16_t* WT; int Kd, Nd, n0, k0; bool map; };
constexpr int TI_IN = 112 * 16, TI_OUT = 16 * 32, TI_XO = 16 * 16, TI_KV = 32 * 16, TI_MAIN = TI_IN + TI_OUT + TI_XO, TI_ALL = TI_MAIN + TI_KV;
__device__ __forceinline__ TDesc tile_desc(KP p, int it) {
    unsigned char* ws = p->ws; TDesc d; d.map = false; int r = it, nn;
    if (r < TI_IN) { d.W = p->w_in; d.WT = (bf16_t*)(ws + WS_WIN); d.Kd = D; d.Nd = IN_DIM; nn = 112; d.map = true; }
    else if ((r -= TI_IN) < TI_OUT) { d.W = p->w_out; d.WT = (bf16_t*)(ws + WS_WOUT); d.Kd = 2 * D; d.Nd = D; nn = 16; }
    else if ((r -= TI_OUT) < TI_XO) { d.W = p->w_xo; d.WT = (bf16_t*)(ws + WS_WXO); d.Kd = D; d.Nd = D; nn = 16; }
    else { r -= TI_XO; d.W = p->w_kv; d.WT = (bf16_t*)(ws + WS_WKV); d.Kd = D; d.Nd = 2 * D; nn = 32; }
    d.n0 = (r % nn) * 64; d.k0 = (r / nn) * 64; return d;
}
__device__ __forceinline__ void transpose_round(KP p, int base, int G, int NI, LAS unsigned char* lds, int tid) {
    const int kl = tid >> 3, seg = tid & 7;
    f32x4 a[4], b[4]; float sc[4];
#pragma unroll
    for (int j = 0; j < 4; ++j) { const int it = base + j * G; if (it < NI) { const TDesc d = tile_desc(p, it);
        const int c0 = d.map ? win_srccol(d.n0 + 8 * seg) : (d.n0 + 8 * seg), c1 = d.map ? win_srccol(d.n0 + 8 * seg + 4) : (d.n0 + 8 * seg + 4);
        a[j] = *(const f32x4*)(d.W + (size_t)(d.k0 + kl) * d.Nd + c0); b[j] = *(const f32x4*)(d.W + (size_t)(d.k0 + kl) * d.Nd + c1); sc[j] = 1.0f; } }
#pragma unroll
    for (int j = 0; j < 4; ++j) { const int it = base + j * G; if (it < NI) {
        const unsigned w0 = cvt_pk_bf16(a[j][0] * sc[j], a[j][1] * sc[j]), w1 = cvt_pk_bf16(a[j][2] * sc[j], a[j][3] * sc[j]), w2 = cvt_pk_bf16(b[j][0] * sc[j], b[j][1] * sc[j]), w3 = cvt_pk_bf16(b[j][2] * sc[j], b[j][3] * sc[j]);
        LAS bf16_t* t = (LAS bf16_t*)(lds + j * 9216) + (8 * seg) * 72 + kl;
        t[0 * 72] = (bf16_t)(w0 & 0xffff); t[1 * 72] = (bf16_t)(w0 >> 16); t[2 * 72] = (bf16_t)(w1 & 0xffff); t[3 * 72] = (bf16_t)(w1 >> 16);
        t[4 * 72] = (bf16_t)(w2 & 0xffff); t[5 * 72] = (bf16_t)(w2 >> 16); t[6 * 72] = (bf16_t)(w3 & 0xffff); t[7 * 72] = (bf16_t)(w3 >> 16); } }
    __syncthreads();
#pragma unroll
    for (int j = 0; j < 4; ++j) { const int it = base + j * G; if (it < NI) { const TDesc d = tile_desc(p, it);
        const u32x4 w = *(const LAS u32x4*)((LAS bf16_t*)(lds + j * 9216) + kl * 72 + 8 * seg); *(u32x4*)(d.WT + (size_t)(d.n0 + kl) * d.Kd + d.k0 + 8 * seg) = w; } }
    __syncthreads();
}

struct SgRegs { u32x4 gv[4]; f32x4 lg0, lg1, lb0, lb1; bf16x8 wf[4]; u32x2 gu[8]; float bsv; };
__device__ __forceinline__ void sg_load_a(KP p, int item, int tid, SgRegs& R) {
    const int h = item & 7, n = (item >> 3) & 31, b = item >> 8; const int t0 = b * SEQ + n * 128, c0 = h * 128; const int chunk = tid & 15, r4 = tid >> 4;
    const bf16_t* GV = (const bf16_t*)(p->ws + WS_GV);
#pragma unroll
    for (int i = 0; i < 4; ++i) R.gv[i] = *(const u32x4*)(GV + (size_t)(t0 + r4 + 32 * i) * D + c0 + 8 * chunk);
    R.lg0 = *(const f32x4*)(p->gm_ln_g + c0 + 8 * chunk); R.lg1 = *(const f32x4*)(p->gm_ln_g + c0 + 8 * chunk + 4);
    R.lb0 = *(const f32x4*)(p->gm_ln_b + c0 + 8 * chunk); R.lb1 = *(const f32x4*)(p->gm_ln_b + c0 + 8 * chunk + 4);
}
__device__ __forceinline__ void sg_load_b(KP p, int item, int tid, SgRegs& R) {
    const int h = item & 7, n = (item >> 3) & 31, b = item >> 8; const int t0 = b * SEQ + n * 128, c0 = h * 128; const int wid = tid >> 6, lane = tid & 63, tt = 16 * wid + (lane & 15);
    const bf16_t* GU = (const bf16_t*)(p->ws + WS_GU); const bf16_t* WSb = (const bf16_t*)(p->ws + WS_WS);
#pragma unroll
    for (int kk = 0; kk < 4; ++kk) R.wf[kk] = *(const bf16x8*)(WSb + ((size_t)h * 128 + tt) * 128 + kk * 32 + (lane >> 4) * 8);
#pragma unroll
    for (int nf = 0; nf < 8; ++nf) R.gu[nf] = *(const u32x2*)(GU + (size_t)(t0 + tt) * D + c0 + 16 * nf + 4 * (lane >> 4));
    R.bsv = p->gm_bs[h * 128 + tt];
}
__device__ __forceinline__ void sg_items(KP p, LAS unsigned char* lds, int first, int step, int end, int tid, bf16_t* GUo) {
    if (first >= end) return;
    const int wid = __builtin_amdgcn_readfirstlane(tid >> 6), lane = tid & 63, chunk = tid & 15, r4 = tid >> 4, tt = 16 * wid + (lane & 15);
    LAS bf16_t* vn = (LAS bf16_t*)lds;
    SgRegs R; sg_load_a(p, first, tid, R); sg_load_b(p, first, tid, R);
    for (int item = first; item < end; item += step) {
        const int h = item & 7, n = (item >> 3) & 31, b = item >> 8; const int t0 = b * SEQ + n * 128, c0 = h * 128; const int next = item + step;
#pragma unroll
        for (int i = 0; i < 4; ++i) {
            float v[8];
#pragma unroll
            for (int q = 0; q < 4; ++q) { v[2 * q] = bf_lo(R.gv[i][q]); v[2 * q + 1] = bf_hi(R.gv[i][q]); }
            float sm = ((v[0] + v[1]) + (v[2] + v[3])) + ((v[4] + v[5]) + (v[6] + v[7]));
            sm += __shfl_xor(sm, 1); sm += __shfl_xor(sm, 2); sm += __shfl_xor(sm, 4); sm += __shfl_xor(sm, 8);
            const float mean = sm * (1.0f / 128.0f); float sq = 0.f;
#pragma unroll
            for (int e = 0; e < 8; ++e) { v[e] -= mean; sq += v[e] * v[e]; }
            sq += __shfl_xor(sq, 1); sq += __shfl_xor(sq, 2); sq += __shfl_xor(sq, 4); sq += __shfl_xor(sq, 8);
            const float rstd = rsqrtf(sq * (1.0f / 128.0f) + EPS);
            u32x4 w; w.x = cvt_pk_bf16(v[0] * rstd * R.lg0[0] + R.lb0[0], v[1] * rstd * R.lg0[1] + R.lb0[1]); w.y = cvt_pk_bf16(v[2] * rstd * R.lg0[2] + R.lb0[2], v[3] * rstd * R.lg0[3] + R.lb0[3]);
            w.z = cvt_pk_bf16(v[4] * rstd * R.lg1[0] + R.lb1[0], v[5] * rstd * R.lg1[1] + R.lb1[1]); w.w = cvt_pk_bf16(v[6] * rstd * R.lg1[2] + R.lb1[2], v[7] * rstd * R.lg1[3] + R.lb1[3]);
            *(LAS u32x4*)(vn + (r4 + 32 * i) * 136 + 8 * chunk) = w;
        }
        __syncthreads();
        if (next < end) sg_load_a(p, next, tid, R);
        f32x4 acc[8];
#pragma unroll
        for (int nf = 0; nf < 8; ++nf) acc[nf] = (f32x4){0.f, 0.f, 0.f, 0.f};
        const int nk = (wid >> 1) + 1;
        const unsigned trb = (unsigned)(size_t)vn + 272u * (8u * (lane >> 4) + ((lane & 15) >> 2)) + 8u * (lane & 3);
#pragma unroll
        for (int kk = 0; kk < 4; ++kk) if (kk < nk) {
            u32x2 r0, r1, r2, r3, r4, r5, r6, r7, r8, r9, r10, r11, r12, r13, r14, r15; const unsigned ad = trb + 272u * 32u * kk;
            asm volatile("ds_read_b64_tr_b16 %0, %16 offset:0\n\tds_read_b64_tr_b16 %1, %16 offset:1088\n\tds_read_b64_tr_b16 %2, %16 offset:32\n\tds_read_b64_tr_b16 %3, %16 offset:1120\n\t"
                         "ds_read_b64_tr_b16 %4, %16 offset:64\n\tds_read_b64_tr_b16 %5, %16 offset:1152\n\tds_read_b64_tr_b16 %6, %16 offset:96\n\tds_read_b64_tr_b16 %7, %16 offset:1184\n\t"
                         "ds_read_b64_tr_b16 %8, %16 offset:128\n\tds_read_b64_tr_b16 %9, %16 offset:1216\n\tds_read_b64_tr_b16 %10, %16 offset:160\n\tds_read_b64_tr_b16 %11, %16 offset:1248\n\t"
                         "ds_read_b64_tr_b16 %12, %16 offset:192\n\tds_read_b64_tr_b16 %13, %16 offset:1280\n\tds_read_b64_tr_b16 %14, %16 offset:224\n\tds_read_b64_tr_b16 %15, %16 offset:1312\n\ts_waitcnt lgkmcnt(0)"
                         : "=&v"(r0), "=&v"(r1), "=&v"(r2), "=&v"(r3), "=&v"(r4), "=&v"(r5), "=&v"(r6), "=&v"(r7), "=&v"(r8), "=&v"(r9), "=&v"(r10), "=&v"(r11), "=&v"(r12), "=&v"(r13), "=&v"(r14), "=&v"(r15)
                         : "v"(ad) : "memory");
#define SG_MM(nf, lo, hi) { u32x4 f; f.x = lo.x; f.y = lo.y; f.z = hi.x; f.w = hi.y; acc[nf] = __builtin_amdgcn_mfma_f32_16x16x32_bf16(__builtin_bit_cast(bf16x8, f), R.wf[kk], acc[nf], 0, 0, 0); }
            SG_MM(0, r0, r1) SG_MM(1, r2, r3) SG_MM(2, r4, r5) SG_MM(3, r6, r7) SG_MM(4, r8, r9) SG_MM(5, r10, r11) SG_MM(6, r12, r13) SG_MM(7, r14, r15)
#undef SG_MM
        }
#pragma unroll
        for (int nf = 0; nf < 8; ++nf) { const u32x2 gw = R.gu[nf];
            u32x2 o; o.x = cvt_pk_bf16(bf_lo(gw.x) * (acc[nf][0] + R.bsv), bf_hi(gw.x) * (acc[nf][1] + R.bsv)); o.y = cvt_pk_bf16(bf_lo(gw.y) * (acc[nf][2] + R.bsv), bf_hi(gw.y) * (acc[nf][3] + R.bsv));
            *(u32x2*)(GUo + (size_t)(t0 + tt) * D + c0 + 16 * nf + 4 * (lane >> 4)) = o; }
        if (next < end) sg_load_b(p, next, tid, R);
        __syncthreads();
    }
}
__device__ __forceinline__ void conv_fixup(KP p, int k, int tid, bf16_t* Ao) {
    const int r = tid >> 8, ch = 4 * (tid & 255); unsigned char* ws = p->ws; const float* cw = p->conv_w;
    const float* HP = (const float*)(ws + WS_HP); const float* HG = (const float*)(ws + WS_HG); const float* TP = (const float*)(ws + WS_TP);
    const f32x4 w0 = *(const f32x4*)(cw + ch), w1 = *(const f32x4*)(cw + D + ch), w2 = *(const f32x4*)(cw + 2 * D + ch);
    const f32x4 ph0 = *(const f32x4*)(HP + ((size_t)k * 2) * D + ch), ph1 = *(const f32x4*)(HP + ((size_t)k * 2 + 1) * D + ch), g = *(const f32x4*)(HG + ((size_t)k * 2 + r) * D + ch);
    f32x4 pt0 = (f32x4){0.f, 0.f, 0.f, 0.f}, pt1 = pt0;
    if (((k * 64) & (SEQ - 1)) != 0) { pt0 = *(const f32x4*)(TP + ((size_t)(k - 1) * 2) * D + ch); pt1 = *(const f32x4*)(TP + ((size_t)(k - 1) * 2 + 1) * D + ch); }
    const f32x4 a = r == 0 ? g * (w2 * ph0 + w1 * pt1 + w0 * pt0) : g * (w2 * ph1 + w1 * ph0 + w0 * pt1);
    u32x2 aw; aw.x = cvt_pk_bf16(a[0], a[1]); aw.y = cvt_pk_bf16(a[2], a[3]);
    *(u32x2*)(Ao + (size_t)(k * 64 + r) * D + ch) = aw;
}

__device__ __forceinline__ void p0_transpose_item(const float* W, int Kd, int Nd, bf16_t* WT, bool map, int n0, int k0, LAS float* scr, int lane) {
    const int nl = lane & 31; const int srcc = map ? win_srccol(n0 + nl) : (n0 + nl);
#pragma unroll 8
    for (int i = 0; i < 32; ++i) { const int kk = 2 * i + (lane >> 5); scr[kk * 33 + nl] = W[(size_t)(k0 + kk) * Nd + srcc]; }
    asm volatile("s_waitcnt lgkmcnt(0)" ::: "memory");
    const int c = lane & 7;
#pragma unroll
    for (int j = 0; j < 4; ++j) { const int n = (lane >> 3) + 8 * j; const LAS float* sp = scr + (8 * c) * 33 + n;
        u32x4 o; o.x = cvt_pk_bf16(sp[0 * 33], sp[1 * 33]); o.y = cvt_pk_bf16(sp[2 * 33], sp[3 * 33]); o.z = cvt_pk_bf16(sp[4 * 33], sp[5 * 33]); o.w = cvt_pk_bf16(sp[6 * 33], sp[7 * 33]);
        *(u32x4*)(WT + (size_t)(n0 + n) * Kd + k0 + 8 * c) = o; }
    asm volatile("s_waitcnt lgkmcnt(0)" ::: "memory");
}
constexpr int PI_IN = 16 * 224, PI_OUT = 32 * 32, PI_XO = 16 * 32, PI_KV = 16 * 64, PI_ALL = PI_IN + PI_OUT + PI_XO + PI_KV;
__device__ __forceinline__ void p0_transpose(KP p, int it, LAS float* scr, int lane) {
    unsigned char* ws = p->ws; int r = it;
    if (r < PI_IN) { p0_transpose_item(p->w_in, D, IN_DIM, (bf16_t*)(ws + WS_WIN), true, (r % 224) * 32, (r / 224) * 64, scr, lane); return; } r -= PI_IN;
    if (r < PI_OUT) { p0_transpose_item(p->w_out, 2 * D, D, (bf16_t*)(ws + WS_WOUT), false, (r % 32) * 32, (r / 32) * 64, scr, lane); return; } r -= PI_OUT;
    if (r < PI_XO) { p0_transpose_item(p->w_xo, D, D, (bf16_t*)(ws + WS_WXO), false, (r % 32) * 32, (r / 32) * 64, scr, lane); return; } r -= PI_XO;
    p0_transpose_item(p->w_kv, D, 2 * D, (bf16_t*)(ws + WS_WKV), false, (r % 64) * 32, (r / 64) * 64, scr, lane);
}
constexpr int NSUB = 32;
__device__ __forceinline__ void sub_arrive(unsigned* word, int wv) {
    asm volatile("s_waitcnt vmcnt(0)" ::: "memory"); __syncthreads();
    if (launder_tid(wv) == 0) { __builtin_amdgcn_fence(__ATOMIC_RELEASE, "agent"); asm volatile("s_waitcnt vmcnt(0)" ::: "memory"); (void)xb_add(word, 1u); }
}
__device__ __forceinline__ void sub_wait(unsigned* word, unsigned target, unsigned* bar, int wv) {
    __syncthreads();
    if (launder_tid(wv) == 0) { XB_SPIN(xb_ld(word) < target, bar); __builtin_amdgcn_fence(__ATOMIC_ACQUIRE, "agent"); asm volatile("s_waitcnt vmcnt(0)" ::: "memory"); }
    __syncthreads();
}
__device__ __forceinline__ void phase0(LAS unsigned char* lds, int wv) {
    KP p = launder_kp(); const int tid = launder_tid(wv), wid = __builtin_amdgcn_readfirstlane(tid >> 6), lane = tid & 63, G = gridDim.x, c = blockIdx.x;
    unsigned char* ws = p->ws;
    { LAS float* scr = (LAS float*)(lds + wid * 8448); for (int it = c * 8 + wid; it < PI_ALL; it += G * 8) p0_transpose(p, it, scr, lane); }
    float* ss = (float*)(ws + WS_SS1);
    for (int i = c * 512 + tid; i < 2 * T; i += G * 512) ss[i] = 0.f;
    { bf16_t* WSb = (bf16_t*)(ws + WS_WS); const float* gws = p->gm_ws;
      for (int i = c * 512 + tid; i < 8 * 128 * 128 / 2; i += G * 512) { const int e = 2 * i, s = e & 127, t = (e >> 7) & 127;
          const float a = (s <= t) ? gws[e] : 0.f, b = (s + 1 <= t) ? gws[e + 1] : 0.f; ((unsigned*)WSb)[i] = cvt_pk_bf16(a, b); } }
    { const float* wq = p->w_q; const float* gx = p->norm_x_g; bf16_t* WqN = (bf16_t*)(ws + WS_WQ);
      for (int idx = c * 512 + tid; idx < D * (D / 16); idx += G * 512) { const int k = idx >> 6, col = (idx & 63) * 16; const float sc = gx[k]; const float* src = wq + (size_t)k * D + col;
          const f32x4 a0 = *(const f32x4*)src, a1 = *(const f32x4*)(src + 4), a2 = *(const f32x4*)(src + 8), a3 = *(const f32x4*)(src + 12);
          u32x4 w0, w1; w0.x = cvt_pk_bf16(a0[0] * sc, a0[1] * sc); w0.y = cvt_pk_bf16(a0[2] * sc, a0[3] * sc); w0.z = cvt_pk_bf16(a1[0] * sc, a1[1] * sc); w0.w = cvt_pk_bf16(a1[2] * sc, a1[3] * sc);
          w1.x = cvt_pk_bf16(a2[0] * sc, a2[1] * sc); w1.y = cvt_pk_bf16(a2[2] * sc, a2[3] * sc); w1.z = cvt_pk_bf16(a3[0] * sc, a3[1] * sc); w1.w = cvt_pk_bf16(a3[2] * sc, a3[3] * sc);
          *(u32x4*)(WqN + (size_t)k * D + col) = w0; *(u32x4*)(WqN + (size_t)k * D + col + 8) = w1; } }
    { const int gw = c * 8 + wid, NGW = G * 8; bf16_t* H = (bf16_t*)(ws + WS_H); bf16_t* MN = (bf16_t*)(ws + WS_MN);
      const float* x = p->x; const float* mem = p->mem; const float* g1 = p->norm_mix_g; const float* g2 = p->norm_mem_g; float* rs0 = (float*)(ws + WS_RS0);
      int r = gw;
      for (; r + NGW < T; r += 2 * NGW) { const float* const xr[2] = {x + (size_t)r * D, x + (size_t)(r + NGW) * D}; bf16_t* const orow[2] = {H + (size_t)r * D, H + (size_t)(r + NGW) * D}; float* const rso[2] = {rs0 + r, rs0 + r + NGW}; rms_rows_to_bf16<2>(xr, g1, orow, lane, rso); }
      for (; r < T; r += NGW) { const float* const xr[1] = {x + (size_t)r * D}; bf16_t* const orow[1] = {H + (size_t)r * D}; float* const rso[1] = {rs0 + r}; rms_rows_to_bf16<1>(xr, g1, orow, lane, rso); }
      for (r = gw; r < NB * MEM; r += NGW) { const float* const xr[1] = {mem + (size_t)r * D}; bf16_t* const orow[1] = {MN + (size_t)r * D}; float* const rso[1] = {nullptr}; rms_rows_to_bf16<1>(xr, g2, orow, lane, rso); } }
}
__device__ __forceinline__ void phase1(LAS unsigned char* lds, int wv) {
    KP p = launder_kp(); unsigned char* ws = p->ws; const int G = gridDim.x, c = blockIdx.x;
    SchedPlain S; S.A0 = (const char*)(ws + WS_H); S.A1 = S.A0; S.Bt = (const char*)(ws + WS_WIN); S.nM = T / 256; S.nN = IN_DIM / 256; S.G = G; S.c = c; S.lda = D; S.ldb = D; S.nt0 = D / 64;
    EpiG1 E; E.A = (bf16_t*)(ws + WS_G); E.GU = (bf16_t*)(ws + WS_GU); E.GV = (bf16_t*)(ws + WS_GV); E.HP = (float*)(ws + WS_HP); E.HG = (float*)(ws + WS_HG); E.TP = (float*)(ws + WS_TP); E.cw = p->conv_w;
    Gemm g; g.lda = D; g.ldb = D; g.K = D; g.nt0 = D / 64;
    pg8::gemm_phase<EpiG1, SchedPlain, true>(lds, g, S, E, wv);
}
__device__ __forceinline__ Unit wp_unit(unsigned char* ws, int bh, int nt) { const int b = bh >> 2, h = bh & 3; Unit u; u.pm = 0; u.pn = nt; u.z = bh;
    u.a0 = (const char*)(ws + WS_KB) + ((size_t)(b * MEM) * 2 * D + h * HD) * 2; u.a1 = u.a0 - (size_t)(HD / 64) * 128; u.b = (const char*)(ws + WS_WQ) + ((size_t)(nt * 256) * D + h * HD) * 2; return u; }
__device__ __forceinline__ Unit vw_unit(unsigned char* ws, int bh, int mt) { const int b = bh >> 2, h = bh & 3; Unit u; u.pm = mt; u.pn = 0; u.z = bh;
    u.a0 = (const char*)(ws + WS_WXO) + ((size_t)(mt * 256) * D + h * HD) * 2; u.a1 = u.a0 - (size_t)(HD / 64) * 128; u.b = (const char*)(ws + WS_KB) + ((size_t)(b * MEM) * 2 * D + D + h * HD) * 2; return u; }
__device__ __forceinline__ void run_wp(LAS unsigned char* lds, int wv, int ui) { KP p = launder_kp(); unsigned char* ws = p->ws; const int bh = ui >> 2;
    SchedOne S; S.u0 = wp_unit(ws, bh, ui & 3); EpiBf E; E.O = (bf16_t*)(ws + WS_WP) + (size_t)bh * 256 * D; E.ld = D;
    Gemm g; g.lda = 2 * D; g.ldb = D; g.K = HD; g.nt0 = HD / 64; pg8::gemm_phase<EpiBf, SchedOne, true>(lds, g, S, E, wv); __syncthreads(); }
__device__ __forceinline__ void run_vw(LAS unsigned char* lds, int wv, int ui) { KP p = launder_kp(); unsigned char* ws = p->ws; const int bh = ui >> 2, b = bh >> 2, h = bh & 3;
    SchedOne S; S.u0 = vw_unit(ws, bh, ui & 3); EpiBf E; E.O = (bf16_t*)(ws + WS_VW) + (size_t)b * D * D + h * HD; E.ld = D;
    Gemm g; g.lda = D; g.ldb = 2 * D; g.K = HD; g.nt0 = HD / 64; pg8::gemm_phase<EpiBf, SchedOne, true>(lds, g, S, E, wv); __syncthreads(); }
__device__ __forceinline__ void phase2(LAS unsigned char* lds, int wv, bool dry, int mask) {
    const int G = gridDim.x, c = blockIdx.x;
    if (mask & 4) { KP p = launder_kp(); const int tid = launder_tid(wv); bf16_t* Go = (bf16_t*)(p->ws + (dry ? (size_t)220 * MB : WS_G));
      for (int it = c; it < T / 64; it += G) conv_fixup(p, it, tid, Go); }
    unsigned* subw = (unsigned*)(launder_kp()->ws + WS_SUB) + (dry ? 64 : 0); unsigned* bar = (unsigned*)(launder_kp()->ws + WS_BAR);
    if (c < NSUB) {
        if (mask & 1) { { KP p = launder_kp(); unsigned char* ws = p->ws;
          SchedPlain S; S.A0 = (const char*)(ws + WS_MN); S.A1 = S.A0; S.Bt = (const char*)(ws + WS_WKV); S.nM = NB * MEM / 256; S.nN = 2 * D / 256; S.G = NSUB; S.c = c; S.lda = D; S.ldb = D; S.nt0 = D / 64;
          EpiBf E; E.O = (bf16_t*)(ws + WS_KB); E.ld = 2 * D;
          Gemm g; g.lda = D; g.ldb = D; g.K = D; g.nt0 = D / 64;
          pg8::gemm_phase<EpiBf, SchedPlain, true>(lds, g, S, E, wv); }
          sub_arrive(subw, wv); sub_wait(subw, NSUB, bar, wv); run_vw(lds, wv, c); }
    } else if (c < NSUB + 64) {
        if (mask & 2) { KP p = launder_kp(); const int tid = launder_tid(wv); bf16_t* GUo = (bf16_t*)(p->ws + (dry ? (size_t)220 * MB : WS_GU));
          sg_items(p, lds, c - NSUB, 96, 384, tid, GUo); }
        if (mask & 1) { sub_wait(subw, NSUB, bar, wv); run_wp(lds, wv, c - NSUB); }
    } else if (c < NSUB + 96) {
        if (mask & 2) { KP p = launder_kp(); const int tid = launder_tid(wv); bf16_t* GUo = (bf16_t*)(p->ws + (dry ? (size_t)220 * MB : WS_GU));
          sg_items(p, lds, c - NSUB, 96, 384, tid, GUo); }
        if (mask & 1) { sub_wait(subw, NSUB, bar, wv); run_vw(lds, wv, c - NSUB - 64 + 32); }
    } else {
        if (mask & 2) { KP p = launder_kp(); const int tid = launder_tid(wv); bf16_t* GUo = (bf16_t*)(p->ws + (dry ? (size_t)220 * MB : WS_GU));
          sg_items(p, lds, 384 + (c - 128), 128, 1024, tid, GUo); }
    }
}
__device__ __forceinline__ void phase3(LAS unsigned char* lds, int wv, bool dry) {
    KP p = launder_kp(); unsigned char* ws = p->ws; const int G = gridDim.x, c = blockIdx.x;
    SchedPlain S; S.A0 = (const char*)(ws + WS_G); S.A1 = (const char*)(ws + WS_GU); S.Bt = (const char*)(ws + WS_WOUT); S.nM = T / 256; S.nN = D / 256; S.G = G; S.c = c; S.lda = D; S.ldb = 2 * D; S.nt0 = D / 64;
    EpiX1 E; E.hb = (bf16_t*)(ws + WS_H); E.rs0 = (const float*)(ws + WS_RS0); E.g = p->norm_mix_g; E.rowss = (float*)(ws + WS_SS1);
    Gemm g; g.lda = D; g.ldb = 2 * D; g.K = 2 * D; g.nt0 = D / 64;
    pg8::gemm_phase<EpiX1, SchedPlain, true>(lds, g, S, E, wv);
}
__device__ __forceinline__ void local_fence() {
    asm volatile("s_waitcnt vmcnt(0)" ::: "memory"); __syncthreads();
    __builtin_amdgcn_fence(__ATOMIC_ACQUIRE, "agent"); asm volatile("s_waitcnt vmcnt(0)" ::: "memory"); __syncthreads();
}
__device__ __forceinline__ void phase456(LAS unsigned char* lds, int wv) {
    const int G = gridDim.x, c = blockIdx.x;
    for (int i = 0;; ++i) {
        int pm, pn; if (!pg8::static_order(T / 256, D / 256, G, c, i, pm, pn)) break;
        const int b = pm >> 4, h = pn, bh = b * 4 + h;
        KP p = launder_kp(); unsigned char* ws = p->ws;
        SchedOne S; S.u0.pm = pm; S.u0.pn = pn; S.u0.z = bh;
        S.u0.a0 = (const char*)(ws + WS_H) + (size_t)pm * 256 * D * 2; S.u0.a1 = S.u0.a0 - (size_t)(D / 64) * 128;
        S.u0.b = (const char*)(ws + WS_WP) + (size_t)bh * 256 * D * 2;
        EpiS E; E.Pb = (bf16_t*)(ws + WS_GV); E.rowss = (const float*)(ws + WS_SS1); E.grow0 = pm * 256; E.hcol = h * HD;
        Gemm g; g.lda = D; g.ldb = D; g.K = D; g.nt0 = D / 64;
        pg8::gemm_phase<EpiS, SchedOne, false>(lds, g, S, E, wv);
    }
}
__device__ __forceinline__ void phase7(LAS unsigned char* lds, int wv, bool dry) {
    KP p = launder_kp(); unsigned char* ws = p->ws; const int G = gridDim.x, c = blockIdx.x;
    int pm, pn; pg8::static_order(T / 256, D / 256, G, c, 0, pm, pn);
    SchedOne S; S.u0.pm = pm; S.u0.pn = pn; S.u0.z = 0;
    S.u0.a0 = (const char*)(ws + WS_GV) + (size_t)pm * 256 * D * 2; S.u0.a1 = S.u0.a0 - (size_t)(D / 64) * 128; S.u0.b = (const char*)(ws + WS_VW) + ((size_t)(pm >> 4) * D + pn * 256) * D * 2;
    EpiFinal E; E.xb = (const bf16_t*)(ws + WS_H); E.out = dry ? (float*)(ws + WS_G) : p->out; E.gf = p->norm_final_g; E.slots = (float*)(ws + WS_SLOT) + (dry ? 65536 : 0);
    E.cnt = (unsigned*)(ws + WS_CNT) + (dry ? 32 : 0); E.bar = (unsigned*)(ws + WS_BAR);
    Gemm g; g.lda = D; g.ldb = D; g.K = D; g.nt0 = D / 64;
    pg8::gemm_phase<EpiFinal, SchedOne, false>(lds, g, S, E, wv);
}

__global__ __launch_bounds__(512, 2) void fwd_megakernel(Params p_unused) {
    extern __shared__ __attribute__((aligned(16))) unsigned char shm[];
    LAS unsigned char* lds = (LAS unsigned char*)shm;
    volatile LAS unsigned* st = (volatile LAS unsigned*)(lds + pg8::STAGE_BYTES);
    const int wv = __builtin_amdgcn_readfirstlane((int)(threadIdx.x >> 6));
    if (launder_tid(wv) == 0) { st[0] = 0u; st[1] = 0u; (void)xb_add((unsigned*)(launder_kp()->ws + WS_BAR) + XB_XCNT(xb_xcc_id()), 1u); }
    __syncthreads();
    if (gridDim.y == 12345u) cg::this_grid().sync();
#define GRID_SYNC() xcd_barrier(st, wv)
    for (int r = 0; r < REP_P0; ++r) { phase0(lds, wv); GRID_SYNC(); }
    for (int r = 0; r < REP_P1; ++r) { phase1(lds, wv); GRID_SYNC(); }
    for (int r = 0; r < EXTRA_SYNCS; ++r) GRID_SYNC();
    if (PROBE_P2_MASK) { phase2(lds, wv, true, PROBE_P2_MASK); GRID_SYNC(); }
    phase2(lds, wv, false, 7); GRID_SYNC();
    for (int r = REP_P3 - 1; r >= 0; --r) { phase3(lds, wv, r > 0); GRID_SYNC(); }
    phase456(lds, wv); GRID_SYNC();
    for (int r = REP_P7 - 1; r >= 0; --r) { phase7(lds, wv, r > 0); if (r > 0) GRID_SYNC(); }
}

extern "C" void kernel_launch(void* const* d_in, const int* in_sizes, int n_in, void* d_out, int out_size, void* d_ws, size_t ws_size, hipStream_t stream) {
    constexpr size_t kDynLds = pg8::STAGE_BYTES + 16;
    static int grid_blocks = 0;
    if (!grid_blocks) {
        if (n_in != 16 || in_sizes[0] != T * D || out_size != T * D || ws_size < WS_END) { fprintf(stderr, "kernel_launch: unexpected shapes (n_in %d, in0 %d, out %d, ws %zu)\n", n_in, n_in > 0 ? in_sizes[0] : -1, out_size, ws_size); grid_blocks = -1; return; }
        int dev = 0, cus = 0, per_cu = 0;
        hipGetDevice(&dev);
        hipDeviceGetAttribute(&cus, hipDeviceAttributeMultiprocessorCount, dev);
        if (hipFuncSetAttribute((const void*)fwd_megakernel, hipFuncAttributeMaxDynamicSharedMemorySize, (int)kDynLds) != hipSuccess) { fprintf(stderr, "kernel_launch: hipFuncSetAttribute failed\n"); }
        hipOccupancyMaxActiveBlocksPerMultiprocessor(&per_cu, (const void*)fwd_megakernel, 512, kDynLds);
        if (per_cu < 1) { fprintf(stderr, "kernel_launch: occupancy query says %d blocks per CU\n", per_cu); per_cu = 1; }
        (void)hipGetLastError();
        if (cus != 256) { fprintf(stderr, "kernel_launch: built for a 256-CU device (one 512-thread workgroup per CU, one 256x256 unit per workgroup in the fused phases); got %d CUs\n", cus); grid_blocks = -1; return; }
        grid_blocks = cus;
    }
    if (grid_blocks < 0) return;
    if (hipMemsetAsync((char*)d_ws + WS_BAR, 0, 49152, stream) != hipSuccess) { fprintf(stderr, "kernel_launch: memset of the barrier words failed\n"); return; }
    Params p{};
    const float** pp = (const float**)&p;
    for (int i = 0; i < 16; ++i) pp[i] = (const float*)d_in[i];
    p.out = (float*)d_out; p.ws = (unsigned char*)d_ws;
    void* args[] = {&p};
    hipError_t e = hipLaunchCooperativeKernel((const void*)fwd_megakernel, dim3(grid_blocks), dim3(512), args, kDynLds, stream);
    if (e != hipSuccess) fprintf(stderr, "cooperative launch failed: %s (grid %d)\n", hipGetErrorString(e), grid_blocks);
}
```

```cpp
#include <hip/hip_runtime.h>
#include <hip/hip_cooperative_groups.h>
#include <cstdio>
#include <cstdint>
namespace cg = cooperative_groups;
#define REP_P0 1
#define REP_P1 1
#define EXTRA_SYNCS 0
#define PROBE_P2_MASK 0
#define PROBE_EPI2 0
#define REP_P3 1
#define REP_P7 1

#define LAS __attribute__((address_space(3)))
typedef unsigned short bf16_t;
typedef short bf16x8 __attribute__((ext_vector_type(8)));
typedef float f32x4 __attribute__((ext_vector_type(4)));
typedef unsigned u32x4 __attribute__((ext_vector_type(4)));
typedef unsigned u32x2 __attribute__((ext_vector_type(2)));

constexpr int D = 1024, NB = 4, SEQ = 4096, T = NB * SEQ, MEM = 256, IN_DIM = 7168, HD = 256, NH = 4;
constexpr float EPS = 1e-6f;
constexpr float LOG2E = 1.4426950408889634f;

constexpr size_t MB = 1024 * 1024;
constexpr size_t WS_H = 0 * MB;
constexpr size_t WS_P = 32 * MB;
constexpr size_t WS_HP = 32 * MB;
constexpr size_t WS_HG = 34 * MB;
constexpr size_t WS_TP = 36 * MB;
constexpr size_t WS_G = 64 * MB;
constexpr size_t WS_GU = 96 * MB;
constexpr size_t WS_GV = 128 * MB;
constexpr size_t WS_WIN = 160 * MB;
constexpr size_t WS_WOUT = 174 * MB;
constexpr size_t WS_WQ = 178 * MB;
constexpr size_t WS_WKV = 180 * MB;
constexpr size_t WS_WXO = 184 * MB;
constexpr size_t WS_MN = 186 * MB;
constexpr size_t WS_KB = 188 * MB;
constexpr size_t WS_SS1 = 192 * MB;
constexpr size_t WS_SS2 = WS_SS1 + 65536;
constexpr size_t WS_WS = WS_SS2 + 65536;
constexpr size_t WS_BAR = WS_WS + 262144;
constexpr size_t WS_CNT = WS_BAR + 16384;
constexpr size_t WS_SUB = WS_CNT + 16384;
constexpr size_t WS_SLOT = WS_SUB + 16384;
constexpr size_t WS_RS0 = 197 * MB;
constexpr size_t WS_WP = 200 * MB;
constexpr size_t WS_VW = 208 * MB;
constexpr size_t WS_END = 216 * MB;

struct Params {
    const float *x, *mem, *norm_mix_g, *w_in, *conv_w, *gm_ln_g, *gm_ln_b, *gm_ws, *gm_bs, *w_out, *norm_x_g, *norm_mem_g, *w_q, *w_kv, *w_xo, *norm_final_g;
    float* out; unsigned char* ws;
};

typedef const __attribute__((address_space(4))) Params* KP;
__device__ __forceinline__ KP launder_kp() { KP kp = (KP)__builtin_amdgcn_kernarg_segment_ptr(); asm volatile("" : "+s"(kp)); return kp; }
__device__ __forceinline__ int launder_tid(int wv) { int w = wv; asm volatile("" : "+s"(w)); int l; asm volatile("v_mbcnt_lo_u32_b32 %0, -1, 0\n\tv_mbcnt_hi_u32_b32 %0, -1, %0" : "=v"(l)); return (w << 6) | l; }
__device__ __forceinline__ unsigned cvt_pk_bf16(float lo, float hi) { unsigned r; asm volatile("v_cvt_pk_bf16_f32 %0, %1, %2" : "=v"(r) : "v"(lo), "v"(hi)); return r; }
__device__ __forceinline__ float bf_lo(unsigned w) { return __uint_as_float(w << 16); }
__device__ __forceinline__ float bf_hi(unsigned w) { return __uint_as_float(w & 0xffff0000u); }
__device__ __forceinline__ float bf2f(bf16_t b) { return __uint_as_float(((unsigned)b) << 16); }
__device__ __forceinline__ float wave_sum(float v) {
#pragma unroll
    for (int o = 1; o < 64; o <<= 1) v += __shfl_xor(v, o);
    return v;
}
__device__ __forceinline__ float shfl_xor_l(float v, int m, int lane) { return __int_as_float(__builtin_amdgcn_ds_bpermute((lane ^ m) << 2, __float_as_int(v))); }
typedef float f32x2 __attribute__((ext_vector_type(2)));
__device__ __forceinline__ float silu_f(float z) { return z * __builtin_amdgcn_rcpf(1.0f + __builtin_amdgcn_exp2f(-z * LOG2E)); }
constexpr float GC1 = -2.0f * 0.7978845608028654f * LOG2E, GC2 = GC1 * 0.044715f;
__device__ __forceinline__ f32x2 gelu_pk(f32x2 x) {
    const f32x2 a = x * (x * x * GC2 + GC1);
    f32x2 e; e.x = __builtin_amdgcn_exp2f(a.x); e.y = __builtin_amdgcn_exp2f(a.y);
    const f32x2 d = e + 1.0f; f32x2 r; r.x = __builtin_amdgcn_rcpf(d.x); r.y = __builtin_amdgcn_rcpf(d.y);
    return x * r;
}
__device__ __forceinline__ f32x2 gelu_silu_pk(f32x2 u, f32x2 z) {
    const f32x2 a = u * (u * u * GC2 + GC1), b = z * (-LOG2E);
    f32x2 ea, eb; ea.x = __builtin_amdgcn_exp2f(a.x); ea.y = __builtin_amdgcn_exp2f(a.y); eb.x = __builtin_amdgcn_exp2f(b.x); eb.y = __builtin_amdgcn_exp2f(b.y);
    const f32x2 d = (ea + 1.0f) * (eb + 1.0f); f32x2 r; r.x = __builtin_amdgcn_rcpf(d.x); r.y = __builtin_amdgcn_rcpf(d.y);
    return (u * z) * r;
}

#define XB_TMO      128
#define XB_XCNT(j)  (256  + 64 * (j))
#define XB_XSUB(j)  (1280 + 64 * (j))
#define XB_XGEN(j)  (2304 + 64 * (j))
#define XB_TOP      3328
#define XB_TOPGEN   3392
#define XCD_BAR_WORDS 3456
#define XB_SPIN_CAP (1u << 18)
__device__ __forceinline__ unsigned xb_ld(unsigned* p)              { return __hip_atomic_load(p, __ATOMIC_RELAXED, __HIP_MEMORY_SCOPE_AGENT); }
__device__ __forceinline__ unsigned xb_add(unsigned* p, unsigned v) { return __hip_atomic_fetch_add(p, v, __ATOMIC_RELAXED, __HIP_MEMORY_SCOPE_AGENT); }
__device__ __forceinline__ unsigned xb_xcc_id() { return (unsigned)__builtin_amdgcn_s_getreg((3 << 11) | 20) & 0xFu; }
#define XB_SPIN(cond, bar) do { unsigned _sp = 0; while (cond) { __builtin_amdgcn_s_sleep(1); \
    if ((++_sp & 255u) == 0u) { if (xb_ld(&(bar)[XB_TMO])) break; if (_sp > XB_SPIN_CAP) { atomicAdd(&(bar)[XB_TMO], 1u); break; } } } } while (0)
__device__ __forceinline__ void xcd_barrier_complete(unsigned* bar, unsigned x, unsigned& nloc, unsigned& nx) {
    const unsigned G = gridDim.x * gridDim.y * gridDim.z;
    unsigned sum, cnt, mine, sp = 0u;
    for (;;) {
        sum = 0u; cnt = 0u; mine = 0u;
#pragma unroll
        for (unsigned j = 0; j < 16; ++j) { const unsigned c = xb_ld(&bar[XB_XCNT(j)]); sum += c; cnt += (c > 0u) ? 1u : 0u; mine = (j == x) ? c : mine; }
        if (sum == G) break;
        __builtin_amdgcn_s_sleep(1);
        if ((++sp & 255u) == 0u) { if (xb_ld(&bar[XB_TMO])) break; if (sp > XB_SPIN_CAP) { atomicAdd(&bar[XB_TMO], 1u); break; } }
    }
    nloc = mine > 0u ? mine : 1u; nx = cnt > 0u ? cnt : 1u;
}
__device__ __forceinline__ void xcd_barrier(volatile LAS unsigned* st, int wv) {
    asm volatile("s_waitcnt vmcnt(0)" ::: "memory");
    __syncthreads();
    if (launder_tid(wv) == 0) {
        unsigned* bar = (unsigned*)(launder_kp()->ws + WS_BAR);
        const unsigned x = xb_xcc_id();
        __builtin_amdgcn_s_waitcnt(0);
        unsigned nloc = st[0], nx = st[1];
        if (nloc == 0u) { xcd_barrier_complete(bar, x, nloc, nx); st[0] = nloc; st[1] = nx; }
        const unsigned old = xb_add(&bar[XB_XSUB(x)], 1u);
        const unsigned gen = old / nloc;
        if (old + 1u == (gen + 1u) * nloc) {
            __builtin_amdgcn_fence(__ATOMIC_RELEASE, "agent");
            asm volatile("s_waitcnt vmcnt(0)" ::: "memory");
            const unsigned og = xb_add(&bar[XB_TOP], 1u);
            const unsigned tg = og / nx;
            if (og + 1u == (tg + 1u) * nx) xb_add(&bar[XB_TOPGEN], 1u);
            else XB_SPIN(xb_ld(&bar[XB_TOPGEN]) == tg, bar);
            __builtin_amdgcn_fence(__ATOMIC_ACQUIRE, "agent");
            xb_add(&bar[XB_XGEN(x)], 1u);
            asm volatile("s_waitcnt vmcnt(0)" ::: "memory");
        } else {
            XB_SPIN(xb_ld(&bar[XB_XGEN(x)]) == gen, bar);
            __builtin_amdgcn_fence(__ATOMIC_ACQUIRE, "agent");
            asm volatile("s_waitcnt vmcnt(0)" ::: "memory");
        }
    }
    __syncthreads();
}

namespace pg8 {
constexpr int BM = 256, BK = 64, HALF = 128, HTB = HALF * BK * 2, STAGE_BYTES = 8 * HTB, NXCD = 8, WGM = 4;
__host__ __device__ __forceinline__ int lds_byte(int r, int c) { const int st = (r >> 4) * 2 + (c >> 5), rr = r & 15, cc = c & 31, ob = rr * 64 + cc * 2; return st * 1024 + (ob ^ (((ob >> 9) & 1) << 5)); }
__host__ __device__ __forceinline__ void stage_rc(int b, int& R, int& C) { const int st = b / 1024, sb = b % 1024, swz = sb ^ (((sb >> 9) & 1) << 5); R = (st >> 1) * 16 + swz / 64; C = (st & 1) * 32 + (swz % 64) / 2; }
__host__ __device__ __forceinline__ int perm32(int rho) { const int n = rho >> 4, i = rho & 15; return 8 * (i >> 2) + 4 * n + (i & 3); }

struct Unit { const char* a0; const char* a1; const char* b; int pm, pn, z; };
struct Gemm { int lda, ldb, K, nt0; };

__device__ __forceinline__ bool static_order(int nM, int nN, int G, int c, int i, int& pm, int& pn) {
    const int nwg = nM * nN; const long L = (long)i * G + c; if (L >= nwg) return false;
    int wgid = (int)L; { const int q = nwg / NXCD, r = nwg % NXCD, xcd = wgid % NXCD, off = wgid / NXCD; wgid = (xcd < r ? xcd * (q + 1) : r * (q + 1) + (xcd - r) * q) + off; }
    const int nig = WGM * nN, gid = wgid / nig, fm = gid * WGM, gsz = (nM - fm) < WGM ? (nM - fm) : WGM;
    pm = fm + ((wgid % nig) % gsz); pn = (wgid % nig) / gsz; return true;
}

template <class Epi, class Sched, bool ALIGN_EPI>
__device__ __forceinline__ void gemm_phase(LAS unsigned char* lds, const Gemm g, const Sched& S, const Epi& E, int wv) {
    const int tid = launder_tid(wv), wid = __builtin_amdgcn_readfirstlane(tid >> 6), lane = tid & 63, wr = wid >> 2, wc = wid & 3, fr = lane & 15, fq = lane >> 4;
    const int nt = g.K / BK;
    unsigned voffA[2], voffB[2];
#pragma unroll
    for (int i = 0; i < 2; ++i) { int R, C; stage_rc(tid * 16 + i * 8192, R, C); const int Rb = Epi::PERM ? ((R & ~31) + perm32(R & 31)) : R;
        voffA[i] = (unsigned)(R * g.lda + C) * 2u; voffB[i] = (unsigned)(Rb * g.ldb + C) * 2u; }
    const size_t kstep = (size_t)(BK * 2);
    const size_t hstepA = (size_t)HALF * g.lda * 2, hstepB = (size_t)HALF * g.ldb * 2;
    const unsigned ldsw = (unsigned)wid * 1024u;
    const int aoff = lds_byte(wr * 64 + fr, fq * 8), boff = lds_byte(wc * 32 + fr, fq * 8);
    const int nt0 = g.nt0;
#define PG8_AP(u, kt) (((kt) < nt0 ? (u).a0 : (u).a1) + (size_t)(kt) * kstep)
#define PG8_SA(b, h) (((b) * 2 + (h)) * HTB)
#define PG8_SB(b, h) ((4 + (b) * 2 + (h)) * HTB)
#define PG8_STAGE(bufoff, gbase, voff) do { _Pragma("unroll") for (int _i = 0; _i < 2; ++_i) \
        __builtin_amdgcn_global_load_lds((const unsigned*)((const char*)(gbase) + (voff)[_i]), (LAS unsigned*)(lds + (bufoff) + ldsw + _i * 8192), 16, 0, 0); } while (0)
#define PG8_LDA(dst, b, h) do { _Pragma("unroll") for (int m = 0; m < 4; ++m) _Pragma("unroll") for (int k = 0; k < 2; ++k) dst[m][k] = *(const LAS bf16x8*)(lds + PG8_SA(b, h) + aoff + m * 2048 + k * 1024); } while (0)
#define PG8_LDB(dst, b, h) do { _Pragma("unroll") for (int n = 0; n < 2; ++n) _Pragma("unroll") for (int k = 0; k < 2; ++k) dst[n][k] = *(const LAS bf16x8*)(lds + PG8_SB(b, h) + boff + n * 2048 + k * 1024); } while (0)
#define PG8_MMA(ai, bj, At, Bt) do { __builtin_amdgcn_s_setprio(1); _Pragma("unroll") for (int m = 0; m < 4; ++m) _Pragma("unroll") for (int n = 0; n < 2; ++n) _Pragma("unroll") for (int k = 0; k < 2; ++k) \
        acc[ai][bj][m][n] = __builtin_amdgcn_mfma_f32_16x16x32_bf16(Bt[n][k], At[m][k], acc[ai][bj][m][n], 0, 0, 0); __builtin_amdgcn_s_setprio(0); } while (0)
#define PG8_WAIT_V(n) asm volatile("s_waitcnt vmcnt(" #n ")" ::: "memory")
#define PG8_WAIT_L(n) asm volatile("s_waitcnt lgkmcnt(" #n ")" ::: "memory")
#define PG8_BAR __builtin_amdgcn_s_barrier()
#define PG8_SCHED __builtin_amdgcn_sched_barrier(0)
    Unit cur, nxt; int ui = 0;
    if (!S.next(0, cur)) return;
    f32x4 acc[2][2][4][2];
#pragma unroll
    for (int a = 0; a < 2; ++a)
#pragma unroll
        for (int b = 0; b < 2; ++b)
#pragma unroll
            for (int m = 0; m < 4; ++m)
#pragma unroll
                for (int n = 0; n < 2; ++n) acc[a][b][m][n] = (f32x4){0.f, 0.f, 0.f, 0.f};
    bf16x8 At[4][2], B0[2][2], B1[2][2];
    const char* cB = cur.b;
    {
        const char* p0 = PG8_AP(cur, 0); const char* p1 = PG8_AP(cur, 1);
        PG8_STAGE(PG8_SB(0, 0), cB, voffB); PG8_STAGE(PG8_SB(0, 1), cB + hstepB, voffB); PG8_STAGE(PG8_SA(0, 0), p0, voffA); PG8_STAGE(PG8_SA(0, 1), p0 + hstepA, voffA);
        if (wr == 1) PG8_BAR;
        PG8_WAIT_V(2); PG8_BAR;
        PG8_STAGE(PG8_SB(1, 0), cB + kstep, voffB); PG8_STAGE(PG8_SA(1, 0), p1, voffA); PG8_STAGE(PG8_SB(1, 1), cB + hstepB + kstep, voffB);
        PG8_WAIT_V(6); PG8_BAR;
    }
    for (;;) {
        const bool has_next = S.next(ui + 1, nxt);
        if (!has_next) nxt = cur;
        const char* nB = nxt.b;
        for (int t = 0; t < nt; t += 2) {
            const bool last = (t == nt - 2);
            const char* a1 = PG8_AP(cur, t + 1);
            const char* a2 = last ? PG8_AP(nxt, 0) : PG8_AP(cur, t + 2); const char* b2 = last ? nB : cB + (size_t)(t + 2) * kstep;
            const char* a3 = last ? PG8_AP(nxt, 1) : PG8_AP(cur, t + 3); const char* b3 = b2 + kstep;
            PG8_LDB(B0, 0, 0); PG8_LDB(B1, 0, 1); PG8_SCHED; PG8_LDA(At, 0, 0); PG8_STAGE(PG8_SA(1, 1), a1 + hstepA, voffA);
            PG8_WAIT_V(8); PG8_WAIT_L(0); PG8_BAR; PG8_MMA(0, 0, At, B0); PG8_MMA(0, 1, At, B1); PG8_BAR; PG8_SCHED;
            PG8_LDA(At, 0, 1); PG8_STAGE(PG8_SB(0, 0), b2, voffB); PG8_STAGE(PG8_SB(0, 1), b2 + hstepB, voffB); PG8_STAGE(PG8_SA(0, 0), a2, voffA);
            PG8_WAIT_V(8); PG8_WAIT_L(0); PG8_BAR; PG8_MMA(1, 0, At, B0); PG8_MMA(1, 1, At, B1); PG8_BAR; PG8_SCHED;
            PG8_LDB(B0, 1, 0); PG8_LDB(B1, 1, 1); PG8_SCHED; PG8_LDA(At, 1, 0); PG8_STAGE(PG8_SA(0, 1), a2 + hstepA, voffA);
            PG8_WAIT_V(8); PG8_WAIT_L(0); PG8_BAR; PG8_MMA(0, 0, At, B0); PG8_MMA(0, 1, At, B1); PG8_BAR; PG8_SCHED;
            PG8_LDA(At, 1, 1); PG8_STAGE(PG8_SB(1, 0), b3, voffB); PG8_STAGE(PG8_SB(1, 1), b3 + hstepB, voffB); PG8_STAGE(PG8_SA(1, 0), a3, voffA);
            PG8_WAIT_V(8); PG8_WAIT_L(0); PG8_BAR; PG8_MMA(1, 0, At, B0); PG8_MMA(1, 1, At, B1); PG8_BAR; PG8_SCHED;
        }
        if constexpr (ALIGN_EPI) { if (wr == 0) PG8_BAR; }
        if constexpr (!Epi::AFTER_DRAIN) { E(acc, cur, wr, wc, fr, fq); if (PROBE_EPI2 && Epi::PROBE2) { asm volatile("" ::: "memory"); E(acc, cur, wr, wc, fr, fq); } }
        if (!has_next) break;
#pragma unroll
        for (int a = 0; a < 2; ++a)
#pragma unroll
            for (int b = 0; b < 2; ++b)
#pragma unroll
                for (int m = 0; m < 4; ++m)
#pragma unroll
                    for (int n = 0; n < 2; ++n) acc[a][b][m][n] = (f32x4){0.f, 0.f, 0.f, 0.f};
        cur = nxt; cB = nB; ++ui;
        if constexpr (ALIGN_EPI) { if (wr == 1) PG8_BAR; }
    }
    PG8_WAIT_V(0);
    if constexpr (!ALIGN_EPI) { if (wr == 0) PG8_BAR; }
    PG8_BAR;
    if constexpr (Epi::AFTER_DRAIN) { E.fused(acc, cur, wr, wc, fr, fq, lds, wid, lane); }
#undef PG8_AP
#undef PG8_SA
#undef PG8_SB
#undef PG8_STAGE
#undef PG8_LDA
#undef PG8_LDB
#undef PG8_MMA
#undef PG8_WAIT_V
#undef PG8_WAIT_L
#undef PG8_BAR
#undef PG8_SCHED
}
}
using pg8::Unit; using pg8::Gemm;

struct SchedPlain {
    const char *A0, *A1, *Bt; int nM, nN, G, c, lda, ldb, nt0;
    __device__ __forceinline__ bool next(int i, Unit& u) const {
        int pm, pn; if (!pg8::static_order(nM, nN, G, c, i, pm, pn)) return false;
        u.pm = pm; u.pn = pn; u.z = 0;
        u.a0 = A0 + (size_t)pm * 256 * lda * 2; u.a1 = A1 + (size_t)pm * 256 * lda * 2 - (size_t)nt0 * 128; u.b = Bt + (size_t)pn * 256 * ldb * 2; return true;
    }
};
struct SchedOne {
    Unit u0;
    __device__ __forceinline__ bool next(int i, Unit& u) const { if (i != 0) return false; u = u0; return true; }
};

struct EpiG1 {
    static constexpr bool PERM = false, AFTER_DRAIN = false, PROBE2 = true;
    bf16_t *A, *GU, *GV; float *HP, *HG, *TP; const float* cw;
    __device__ __forceinline__ void operator()(const f32x4 (&acc)[2][2][4][2], const Unit& u, int wr, int wc, int fr, int fq) const {
        const int row0 = u.pm * 256 + wr * 64 + fr;
        if (u.pn < 16) {
            const int ch = u.pn * 64 + wc * 16 + fq * 4;
            const f32x4 w0 = *(const f32x4*)(cw + ch), w1 = *(const f32x4*)(cw + D + ch), w2 = *(const f32x4*)(cw + 2 * D + ch);
#pragma unroll
            for (int ai = 0; ai < 2; ++ai) {
                const int grp = u.pm * 4 + ai * 2 + wr;
                f32x4 pprev = (f32x4){0.f, 0.f, 0.f, 0.f};
#pragma unroll
                for (int m = 0; m < 4; ++m) {
                    const size_t off = (size_t)(row0 + ai * 128 + m * 16) * D + ch;
                    const f32x4 gb = acc[ai][0][m][0], gc = acc[ai][0][m][1], xa = acc[ai][1][m][0], za = acc[ai][1][m][1];
                    f32x4 pv, gv, av;
#pragma unroll
                    for (int j = 0; j < 4; ++j) { pv[j] = gc[j] * xa[j]; gv[j] = gb[j] * silu_f(za[j]); }
#pragma unroll
                    for (int j = 0; j < 4; ++j) {
                        const int pi = __float_as_int(pv[j]), qi = __float_as_int(pprev[j]);
                        float cv = w2[j] * pv[j];
                        cv = fmaf(__int_as_float(__builtin_amdgcn_update_dpp(0, pi, 0x111, 0xf, 0xf, true)), w1[j], cv);
                        cv = fmaf(__int_as_float(__builtin_amdgcn_update_dpp(0, pi, 0x112, 0xf, 0xf, true)), w0[j], cv);
                        if (m > 0) {
                            cv = fmaf(__int_as_float(__builtin_amdgcn_update_dpp(0, qi, 0x10f, 0xf, 0xf, true)), w1[j], cv);
                            cv = fmaf(__int_as_float(__builtin_amdgcn_update_dpp(0, qi, 0x10e, 0xf, 0xf, true)), w0[j], cv);
                        }
                        av[j] = gv[j] * cv;
                    }
                    u32x2 aw; aw.x = cvt_pk_bf16(av[0], av[1]); aw.y = cvt_pk_bf16(av[2], av[3]);
                    if (m == 0) {
                        if (fr < 2) { *(f32x4*)(HP + ((size_t)grp * 2 + fr) * D + ch) = pv; *(f32x4*)(HG + ((size_t)grp * 2 + fr) * D + ch) = gv; }
                        else *(u32x2*)(A + off) = aw;
                    } else *(u32x2*)(A + off) = aw;
                    if (m == 3 && fr >= 14) *(f32x4*)(TP + ((size_t)grp * 2 + (fr - 14)) * D + ch) = pv;
                    pprev = pv;
                }
            }
        } else if (u.pn < 24) {
            const int ch = (u.pn - 16) * 128 + wc * 32 + fq * 8;
#pragma unroll
            for (int ai = 0; ai < 2; ++ai)
#pragma unroll
                for (int m = 0; m < 4; ++m) {
                    const size_t off = (size_t)(row0 + ai * 128 + m * 16) * D + ch;
                    u32x4 w;
#pragma unroll
                    for (int n = 0; n < 2; ++n)
#pragma unroll
                        for (int j2 = 0; j2 < 2; ++j2) { const f32x2 o = gelu_silu_pk((f32x2){acc[ai][0][m][n][2 * j2], acc[ai][0][m][n][2 * j2 + 1]}, (f32x2){acc[ai][1][m][n][2 * j2], acc[ai][1][m][n][2 * j2 + 1]}); w[n * 2 + j2] = cvt_pk_bf16(o.x, o.y); }
                    *(u32x4*)(GU + off) = w;
                }
        } else {
#pragma unroll
            for (int ai = 0; ai < 2; ++ai)
#pragma unroll
                for (int m = 0; m < 4; ++m)
#pragma unroll
                    for (int bj = 0; bj < 2; ++bj) {
                        const size_t off = (size_t)(row0 + ai * 128 + m * 16) * D + (u.pn - 24) * 256 + bj * 128 + wc * 32 + fq * 8;
                        u32x4 w;
#pragma unroll
                        for (int n = 0; n < 2; ++n)
#pragma unroll
                            for (int j2 = 0; j2 < 2; ++j2) { const f32x2 o = gelu_pk((f32x2){acc[ai][bj][m][n][2 * j2], acc[ai][bj][m][n][2 * j2 + 1]}); w[n * 2 + j2] = cvt_pk_bf16(o.x, o.y); }
                        *(u32x4*)(GV + off) = w;
                    }
        }
    }
};
__device__ __forceinline__ int win_srccol(int np) {
    const int pn = np >> 8, ct = np & 255, bj = ct >> 7, wc = (ct >> 5) & 3, n = (ct >> 4) & 1, fq = (ct >> 2) & 3, j = ct & 3;
    if (pn < 16) return (2 * bj + n) * 1024 + pn * 64 + wc * 16 + fq * 4 + j;
    if (pn < 24) return (bj ? 6 : 4) * 1024 + (pn - 16) * 128 + wc * 32 + fq * 8 + n * 4 + j;
    return 5 * 1024 + (pn - 24) * 256 + bj * 128 + wc * 32 + fq * 8 + n * 4 + j;
}

struct EpiBf {
    static constexpr bool PERM = true, AFTER_DRAIN = false, PROBE2 = false;
    bf16_t* O; int ld;
    __device__ __forceinline__ void operator()(const f32x4 (&acc)[2][2][4][2], const Unit& u, int wr, int wc, int fr, int fq) const {
        const int row0 = u.pm * 256 + wr * 64 + fr, col0 = u.pn * 256 + wc * 32 + fq * 8;
#pragma unroll
        for (int ai = 0; ai < 2; ++ai)
#pragma unroll
            for (int m = 0; m < 4; ++m) { const size_t off = (size_t)(row0 + ai * 128 + m * 16) * ld + col0;
#pragma unroll
                for (int bj = 0; bj < 2; ++bj) { const f32x4 v0 = acc[ai][bj][m][0], v1 = acc[ai][bj][m][1];
                    u32x4 w; w.x = cvt_pk_bf16(v0[0], v0[1]); w.y = cvt_pk_bf16(v0[2], v0[3]); w.z = cvt_pk_bf16(v1[0], v1[1]); w.w = cvt_pk_bf16(v1[2], v1[3]); *(u32x4*)(O + off + bj * 128) = w; }
            }
    }
};
struct EpiX1 {
    static constexpr bool PERM = true, AFTER_DRAIN = false, PROBE2 = false;
    bf16_t* hb; const float* rs0; const float* g; float* rowss;
    __device__ __forceinline__ void operator()(const f32x4 (&acc)[2][2][4][2], const Unit& u, int wr, int wc, int fr, int fq) const {
        const int row0 = u.pm * 256 + wr * 64 + fr, col0 = u.pn * 256 + wc * 32 + fq * 8;
        f32x4 ig[2][2];
#pragma unroll
        for (int bj = 0; bj < 2; ++bj)
#pragma unroll
            for (int n = 0; n < 2; ++n) { const f32x4 gv = *(const f32x4*)(g + col0 + bj * 128 + 4 * n);
#pragma unroll
                for (int j = 0; j < 4; ++j) ig[bj][n][j] = __builtin_amdgcn_rcpf(gv[j]); }
#pragma unroll
        for (int ai = 0; ai < 2; ++ai)
#pragma unroll
            for (int m = 0; m < 4; ++m) {
                const int row = row0 + ai * 128 + m * 16; const size_t off = (size_t)row * D + col0; float ss = 0.f; const float irs = __builtin_amdgcn_rcpf(rs0[row]);
#pragma unroll
                for (int bj = 0; bj < 2; ++bj) { const u32x4 hw = *(const u32x4*)(hb + off + bj * 128);
                    f32x4 v0, v1; v0[0] = bf_lo(hw.x); v0[1] = bf_hi(hw.x); v0[2] = bf_lo(hw.y); v0[3] = bf_hi(hw.y); v1[0] = bf_lo(hw.z); v1[1] = bf_hi(hw.z); v1[2] = bf_lo(hw.w); v1[3] = bf_hi(hw.w);
                    v0 = v0 * irs * ig[bj][0] + acc[ai][bj][m][0]; v1 = v1 * irs * ig[bj][1] + acc[ai][bj][m][1];
                    ss += (v0[0] * v0[0] + v0[1] * v0[1]) + (v0[2] * v0[2] + v0[3] * v0[3]) + (v1[0] * v1[0] + v1[1] * v1[1]) + (v1[2] * v1[2] + v1[3] * v1[3]);
                    u32x4 w; w.x = cvt_pk_bf16(v0[0], v0[1]); w.y = cvt_pk_bf16(v0[2], v0[3]); w.z = cvt_pk_bf16(v1[0], v1[1]); w.w = cvt_pk_bf16(v1[2], v1[3]); *(u32x4*)(hb + off + bj * 128) = w;
                }
                ss += shfl_xor_l(ss, 16, fr + 16 * fq); ss += shfl_xor_l(ss, 32, fr + 16 * fq);
                if (fq == 0) unsafeAtomicAdd(rowss + row, ss);
            }
    }
};
struct EpiFinal {
    static constexpr bool PERM = true, AFTER_DRAIN = true, PROBE2 = false;
    const bf16_t* xb; float* out; const float* gf; float* slots; unsigned* cnt; unsigned* bar;
    __device__ __forceinline__ void fused(f32x4 (&acc)[2][2][4][2], const Unit& u, int wr, int wc, int fr, int fq, LAS unsigned char* lds, int wid, int lane) const {
        LAS float* red = (LAS float*)lds; LAS float* rsl = (LAS float*)(lds + 4096);
        const int tid = wid * 64 + lane, col0 = u.pn * 256 + wc * 32 + fq * 8;
#pragma unroll
        for (int ai = 0; ai < 2; ++ai)
#pragma unroll
            for (int m = 0; m < 4; ++m) { const int rl = ai * 128 + wr * 64 + m * 16 + fr; const size_t off = (size_t)(u.pm * 256 + rl) * D + col0; float ss = 0.f;
#pragma unroll
                for (int bj = 0; bj < 2; ++bj) { const u32x4 xw = *(const u32x4*)(xb + off + bj * 128);
                    f32x4 v0 = acc[ai][bj][m][0], v1 = acc[ai][bj][m][1];
                    v0[0] += bf_lo(xw.x); v0[1] += bf_hi(xw.x); v0[2] += bf_lo(xw.y); v0[3] += bf_hi(xw.y); v1[0] += bf_lo(xw.z); v1[1] += bf_hi(xw.z); v1[2] += bf_lo(xw.w); v1[3] += bf_hi(xw.w);
                    acc[ai][bj][m][0] = v0; acc[ai][bj][m][1] = v1;
                    ss += (v0[0] * v0[0] + v0[1] * v0[1]) + (v0[2] * v0[2] + v0[3] * v0[3]) + (v1[0] * v1[0] + v1[1] * v1[1]) + (v1[2] * v1[2] + v1[3] * v1[3]); }
                ss += shfl_xor_l(ss, 16, fr + 16 * fq); ss += shfl_xor_l(ss, 32, fr + 16 * fq);
                if (fq == 0) red[rl * 4 + wc] = ss; }
        __syncthreads();
        if (tid < 256) { const f32x4 v = *(const LAS f32x4*)(red + tid * 4); __hip_atomic_store(slots + (size_t)(u.pm * 4 + u.pn) * 256 + tid, (v[0] + v[1]) + (v[2] + v[3]), __ATOMIC_RELAXED, __HIP_MEMORY_SCOPE_AGENT); }
        asm volatile("s_waitcnt vmcnt(0)" ::: "memory"); __syncthreads();
        if (tid == 0) { unsigned* cw = cnt + 64 * u.pm; (void)xb_add(cw, 1u); XB_SPIN(xb_ld(cw) < 4u, bar); }
        __syncthreads();
        if (tid < 256) { const float* sp = slots + (size_t)(u.pm * 4) * 256 + tid;
            const float t = (__hip_atomic_load(sp, __ATOMIC_RELAXED, __HIP_MEMORY_SCOPE_AGENT) + __hip_atomic_load(sp + 256, __ATOMIC_RELAXED, __HIP_MEMORY_SCOPE_AGENT)) +
                            (__hip_atomic_load(sp + 512, __ATOMIC_RELAXED, __HIP_MEMORY_SCOPE_AGENT) + __hip_atomic_load(sp + 768, __ATOMIC_RELAXED, __HIP_MEMORY_SCOPE_AGENT));
            rsl[tid] = rsqrtf(t * (1.0f / D) + EPS); }
        __syncthreads();
        f32x4 g4[2][2];
#pragma unroll
        for (int bj = 0; bj < 2; ++bj) { g4[bj][0] = *(const f32x4*)(gf + col0 + bj * 128); g4[bj][1] = *(const f32x4*)(gf + col0 + bj * 128 + 4); }
#pragma unroll
        for (int ai = 0; ai < 2; ++ai)
#pragma unroll
            for (int m = 0; m < 4; ++m) { const int rl = ai * 128 + wr * 64 + m * 16 + fr; const size_t off = (size_t)(u.pm * 256 + rl) * D + col0; const float rs = rsl[rl];
#pragma unroll
                for (int bj = 0; bj < 2; ++bj) { *(f32x4*)(out + off + bj * 128) = acc[ai][bj][m][0] * rs * g4[bj][0]; *(f32x4*)(out + off + bj * 128 + 4) = acc[ai][bj][m][1] * rs * g4[bj][1]; } }
        __syncthreads();
    }
};
struct EpiS {
    static constexpr bool PERM = true, AFTER_DRAIN = true, PROBE2 = false;
    bf16_t* Pb;
    const float* rowss; int grow0, hcol;
    __device__ __forceinline__ void fused(f32x4 (&acc)[2][2][4][2], const Unit& u, int wr, int wc, int fr, int fq, LAS unsigned char* lds, int wid, int lane) const {
        LAS float* rmax = (LAS float*)lds; LAS float* rsum = (LAS float*)(lds + 4096);
        float rsl[2][4];
#pragma unroll
        for (int ai = 0; ai < 2; ++ai)
#pragma unroll
            for (int m = 0; m < 4; ++m) { const int rl = ai * 128 + wr * 64 + m * 16 + fr; float mx = -3.0e38f;
                rsl[ai][m] = rsqrtf(rowss[grow0 + rl] * (1.0f / D) + EPS) * (0.0625f * LOG2E);
#pragma unroll
                for (int bj = 0; bj < 2; ++bj)
#pragma unroll
                    for (int n = 0; n < 2; ++n)
#pragma unroll
                        for (int j = 0; j < 4; ++j) mx = fmaxf(mx, acc[ai][bj][m][n][j]);
                mx = fmaxf(mx, shfl_xor_l(mx, 16, fr + 16 * fq)); mx = fmaxf(mx, shfl_xor_l(mx, 32, fr + 16 * fq));
                if (fq == 0) rmax[rl * 4 + wc] = mx; }
        __syncthreads();
#pragma unroll
        for (int ai = 0; ai < 2; ++ai)
#pragma unroll
            for (int m = 0; m < 4; ++m) { const int rl = ai * 128 + wr * 64 + m * 16 + fr; const f32x4 mv = *(const LAS f32x4*)(rmax + rl * 4);
                const float sc = rsl[ai][m], mx = fmaxf(fmaxf(mv[0], mv[1]), fmaxf(mv[2], mv[3])) * sc; float sm = 0.f;
#pragma unroll
                for (int bj = 0; bj < 2; ++bj)
#pragma unroll
                    for (int n = 0; n < 2; ++n)
#pragma unroll
                        for (int j = 0; j < 4; ++j) { const float e = __builtin_amdgcn_exp2f(fmaf(acc[ai][bj][m][n][j], sc, -mx)); acc[ai][bj][m][n][j] = e; sm += e; }
                sm += shfl_xor_l(sm, 16, fr + 16 * fq); sm += shfl_xor_l(sm, 32, fr + 16 * fq);
                if (fq == 0) rsum[rl * 4 + wc] = sm; }
        __syncthreads();
        const int col0 = wc * 32 + fq * 8;
#pragma unroll
        for (int ai = 0; ai < 2; ++ai)
#pragma unroll
            for (int m = 0; m < 4; ++m) { const int rl = ai * 128 + wr * 64 + m * 16 + fr; const f32x4 sv = *(const LAS f32x4*)(rsum + rl * 4);
                const float inv = 1.0f / ((sv[0] + sv[1]) + (sv[2] + sv[3]));
                bf16_t* dst = Pb + (size_t)(grow0 + rl) * D + hcol + col0;
#pragma unroll
                for (int bj = 0; bj < 2; ++bj) { const f32x4 v0 = acc[ai][bj][m][0] * inv, v1 = acc[ai][bj][m][1] * inv;
                    u32x4 w; w.x = cvt_pk_bf16(v0[0], v0[1]); w.y = cvt_pk_bf16(v0[2], v0[3]); w.z = cvt_pk_bf16(v1[0], v1[1]); w.w = cvt_pk_bf16(v1[2], v1[3]); *(u32x4*)(dst + bj * 128) = w; }
            }
        __syncthreads();
    }
};

template <int NR> __device__ __forceinline__ void rms_rows_to_bf16(const float* const (&xrow)[NR], const float* g, bf16_t* const (&orow)[NR], int lane, float* const (&rso)[NR]) {
    f32x4 v[NR][4];
#pragma unroll
    for (int r = 0; r < NR; ++r)
#pragma unroll
        for (int j = 0; j < 4; ++j) v[r][j] = ((const f32x4*)xrow[r] + lane)[64 * j];
    const f32x4* gr = (const f32x4*)g + lane; f32x4 gg[4];
#pragma unroll
    for (int j = 0; j < 4; ++j) gg[j] = gr[64 * j];
#pragma unroll
    for (int r = 0; r < NR; ++r) { float s = 0.f;
#pragma unroll
        for (int j = 0; j < 4; ++j) s += (v[r][j][0] * v[r][j][0] + v[r][j][1] * v[r][j][1]) + (v[r][j][2] * v[r][j][2] + v[r][j][3] * v[r][j][3]);
        const float rstd = rsqrtf(wave_sum(s) * (1.0f / D) + EPS); u32x2* o8 = (u32x2*)orow[r] + lane; if (rso[r] && lane == 0) *rso[r] = rstd;
#pragma unroll
        for (int j = 0; j < 4; ++j) { u32x2 w; w.x = cvt_pk_bf16(v[r][j][0] * rstd * gg[j][0], v[r][j][1] * rstd * gg[j][1]); w.y = cvt_pk_bf16(v[r][j][2] * rstd * gg[j][2], v[r][j][3] * rstd * gg[j][3]); o8[64 * j] = w; } }
}
struct TDesc { const float* W; bf16_t* WT; int Kd, Nd, n0, k0; bool map; };
constexpr int TI_IN = 112 * 16, TI_OUT = 16 * 32, TI_XO = 16 * 16, TI_KV = 32 * 16, TI_MAIN = TI_IN + TI_OUT + TI_XO, TI_ALL = TI_MAIN + TI_KV;
__device__ __forceinline__ TDesc tile_desc(KP p, int it) {
    unsigned char* ws = p->ws; TDesc d; d.map = false; int r = it, nn;
    if (r < TI_IN) { d.W = p->w_in; d.WT = (bf16_t*)(ws + WS_WIN); d.Kd = D; d.Nd = IN_DIM; nn = 112; d.map = true; }
    else if ((r -= TI_IN) < TI_OUT) { d.W = p->w_out; d.WT = (bf16_t*)(ws + WS_WOUT); d.Kd = 2 * D; d.Nd = D; nn = 16; }
    else if ((r -= TI_OUT) < TI_XO) { d.W = p->w_xo; d.WT = (bf16_t*)(ws + WS_WXO); d.Kd = D; d.Nd = D; nn = 16; }
    else { r -= TI_XO; d.W = p->w_kv; d.WT = (bf16_t*)(ws + WS_WKV); d.Kd = D; d.Nd = 2 * D; nn = 32; }
    d.n0 = (r % nn) * 64; d.k0 = (r / nn) * 64; return d;
}
__device__ __forceinline__ void transpose_round(KP p, int base, int G, int NI, LAS unsigned char* lds, int tid) {
    const int kl = tid >> 3, seg = tid & 7;
    f32x4 a[4], b[4]; float sc[4];
#pragma unroll
    for (int j = 0; j < 4; ++j) { const int it = base + j * G; if (it < NI) { const TDesc d = tile_desc(p, it);
        const int c0 = d.map ? win_srccol(d.n0 + 8 * seg) : (d.n0 + 8 * seg), c1 = d.map ? win_srccol(d.n0 + 8 * seg + 4) : (d.n0 + 8 * seg + 4);
        a[j] = *(const f32x4*)(d.W + (size_t)(d.k0 + kl) * d.Nd + c0); b[j] = *(const f32x4*)(d.W + (size_t)(d.k0 + kl) * d.Nd + c1); sc[j] = 1.0f; } }
#pragma unroll
    for (int j = 0; j < 4; ++j) { const int it = base + j * G; if (it < NI) {
        const unsigned w0 = cvt_pk_bf16(a[j][0] * sc[j], a[j][1] * sc[j]), w1 = cvt_pk_bf16(a[j][2] * sc[j], a[j][3] * sc[j]), w2 = cvt_pk_bf16(b[j][0] * sc[j], b[j][1] * sc[j]), w3 = cvt_pk_bf16(b[j][2] * sc[j], b[j][3] * sc[j]);
        LAS bf16_t* t = (LAS bf16_t*)(lds + j * 9216) + (8 * seg) * 72 + kl;
        t[0 * 72] = (bf16_t)(w0 & 0xffff); t[1 * 72] = (bf16_t)(w0 >> 16); t[2 * 72] = (bf16_t)(w1 & 0xffff); t[3 * 72] = (bf16_t)(w1 >> 16);
        t[4 * 72] = (bf16_t)(w2 & 0xffff); t[5 * 72] = (bf16_t)(w2 >> 16); t[6 * 72] = (bf16_t)(w3 & 0xffff); t[7 * 72] = (bf16_t)(w3 >> 16); } }
    __syncthreads();
#pragma unroll
    for (int j = 0; j < 4; ++j) { const int it = base + j * G; if (it < NI) { const TDesc d = tile_desc(p, it);
        const u32x4 w = *(const LAS u32x4*)((LAS bf16_t*)(lds + j * 9216) + kl * 72 + 8 * seg); *(u32x4*)(d.WT + (size_t)(d.n0 + kl) * d.Kd + d.k0 + 8 * seg) = w; } }
    __syncthreads();
}

struct SgRegs { u32x4 gv[4]; f32x4 lg0, lg1, lb0, lb1; bf16x8 wf[4]; u32x2 gu[8]; float bsv; };
__device__ __forceinline__ void sg_load_a(KP p, int item, int tid, SgRegs& R) {
    const int h = item & 7, n = (item >> 3) & 31, b = item >> 8; const int t0 = b * SEQ + n * 128, c0 = h * 128; const int chunk = tid & 15, r4 = tid >> 4;
    const bf16_t* GV = (const bf16_t*)(p->ws + WS_GV);
#pragma unroll
    for (int i = 0; i < 4; ++i) R.gv[i] = *(const u32x4*)(GV + (size_t)(t0 + r4 + 32 * i) * D + c0 + 8 * chunk);
    R.lg0 = *(const f32x4*)(p->gm_ln_g + c0 + 8 * chunk); R.lg1 = *(const f32x4*)(p->gm_ln_g + c0 + 8 * chunk + 4);
    R.lb0 = *(const f32x4*)(p->gm_ln_b + c0 + 8 * chunk); R.lb1 = *(const f32x4*)(p->gm_ln_b + c0 + 8 * chunk + 4);
}
__device__ __forceinline__ void sg_load_b(KP p, int item, int tid, SgRegs& R) {
    const int h = item & 7, n = (item >> 3) & 31, b = item >> 8; const int t0 = b * SEQ + n * 128, c0 = h * 128; const int wid = tid >> 6, lane = tid & 63, tt = 16 * wid + (lane & 15);
    const bf16_t* GU = (const bf16_t*)(p->ws + WS_GU); const bf16_t* WSb = (const bf16_t*)(p->ws + WS_WS);
#pragma unroll
    for (int kk = 0; kk < 4; ++kk) R.wf[kk] = *(const bf16x8*)(WSb + ((size_t)h * 128 + tt) * 128 + kk * 32 + (lane >> 4) * 8);
#pragma unroll
    for (int nf = 0; nf < 8; ++nf) R.gu[nf] = *(const u32x2*)(GU + (size_t)(t0 + tt) * D + c0 + 16 * nf + 4 * (lane >> 4));
    R.bsv = p->gm_bs[h * 128 + tt];
}
__device__ __forceinline__ void sg_items(KP p, LAS unsigned char* lds, int first, int step, int end, int tid, bf16_t* GUo) {
    if (first >= end) return;
    const int wid = __builtin_amdgcn_readfirstlane(tid >> 6), lane = tid & 63, chunk = tid & 15, r4 = tid >> 4, tt = 16 * wid + (lane & 15);
    LAS bf16_t* vn = (LAS bf16_t*)lds;
    SgRegs R; sg_load_a(p, first, tid, R); sg_load_b(p, first, tid, R);
    for (int item = first; item < end; item += step) {
        const int h = item & 7, n = (item >> 3) & 31, b = item >> 8; const int t0 = b * SEQ + n * 128, c0 = h * 128; const int next = item + step;
#pragma unroll
        for (int i = 0; i < 4; ++i) {
            float v[8];
#pragma unroll
            for (int q = 0; q < 4; ++q) { v[2 * q] = bf_lo(R.gv[i][q]); v[2 * q + 1] = bf_hi(R.gv[i][q]); }
            float sm = ((v[0] + v[1]) + (v[2] + v[3])) + ((v[4] + v[5]) + (v[6] + v[7]));
            sm += __shfl_xor(sm, 1); sm += __shfl_xor(sm, 2); sm += __shfl_xor(sm, 4); sm += __shfl_xor(sm, 8);
            const float mean = sm * (1.0f / 128.0f); float sq = 0.f;
#pragma unroll
            for (int e = 0; e < 8; ++e) { v[e] -= mean; sq += v[e] * v[e]; }
            sq += __shfl_xor(sq, 1); sq += __shfl_xor(sq, 2); sq += __shfl_xor(sq, 4); sq += __shfl_xor(sq, 8);
            const float rstd = rsqrtf(sq * (1.0f / 128.0f) + EPS);
            u32x4 w; w.x = cvt_pk_bf16(v[0] * rstd * R.lg0[0] + R.lb0[0], v[1] * rstd * R.lg0[1] + R.lb0[1]); w.y = cvt_pk_bf16(v[2] * rstd * R.lg0[2] + R.lb0[2], v[3] * rstd * R.lg0[3] + R.lb0[3]);
            w.z = cvt_pk_bf16(v[4] * rstd * R.lg1[0] + R.lb1[0], v[5] * rstd * R.lg1[1] + R.lb1[1]); w.w = cvt_pk_bf16(v[6] * rstd * R.lg1[2] + R.lb1[2], v[7] * rstd * R.lg1[3] + R.lb1[3]);
            *(LAS u32x4*)(vn + (r4 + 32 * i) * 136 + 8 * chunk) = w;
        }
        __syncthreads();
        if (next < end) sg_load_a(p, next, tid, R);
        f32x4 acc[8];
#pragma unroll
        for (int nf = 0; nf < 8; ++nf) acc[nf] = (f32x4){0.f, 0.f, 0.f, 0.f};
        const int nk = (wid >> 1) + 1;
        const unsigned trb = (unsigned)(size_t)vn + 272u * (8u * (lane >> 4) + ((lane & 15) >> 2)) + 8u * (lane & 3);
#pragma unroll
        for (int kk = 0; kk < 4; ++kk) if (kk < nk) {
            u32x2 r0, r1, r2, r3, r4, r5, r6, r7, r8, r9, r10, r11, r12, r13, r14, r15; const unsigned ad = trb + 272u * 32u * kk;
            asm volatile("ds_read_b64_tr_b16 %0, %16 offset:0\n\tds_read_b64_tr_b16 %1, %16 offset:1088\n\tds_read_b64_tr_b16 %2, %16 offset:32\n\tds_read_b64_tr_b16 %3, %16 offset:1120\n\t"
                         "ds_read_b64_tr_b16 %4, %16 offset:64\n\tds_read_b64_tr_b16 %5, %16 offset:1152\n\tds_read_b64_tr_b16 %6, %16 offset:96\n\tds_read_b64_tr_b16 %7, %16 offset:1184\n\t"
                         "ds_read_b64_tr_b16 %8, %16 offset:128\n\tds_read_b64_tr_b16 %9, %16 offset:1216\n\tds_read_b64_tr_b16 %10, %16 offset:160\n\tds_read_b64_tr_b16 %11, %16 offset:1248\n\t"
                         "ds_read_b64_tr_b16 %12, %16 offset:192\n\tds_read_b64_tr_b16 %13, %16 offset:1280\n\tds_read_b64_tr_b16 %14, %16 offset:224\n\tds_read_b64_tr_b16 %15, %16 offset:1312\n\ts_waitcnt lgkmcnt(0)"
                         : "=&v"(r0), "=&v"(r1), "=&v"(r2), "=&v"(r3), "=&v"(r4), "=&v"(r5), "=&v"(r6), "=&v"(r7), "=&v"(r8), "=&v"(r9), "=&v"(r10), "=&v"(r11), "=&v"(r12), "=&v"(r13), "=&v"(r14), "=&v"(r15)
                         : "v"(ad) : "memory");
#define SG_MM(nf, lo, hi) { u32x4 f; f.x = lo.x; f.y = lo.y; f.z = hi.x; f.w = hi.y; acc[nf] = __builtin_amdgcn_mfma_f32_16x16x32_bf16(__builtin_bit_cast(bf16x8, f), R.wf[kk], acc[nf], 0, 0, 0); }
            SG_MM(0, r0, r1) SG_MM(1, r2, r3) SG_MM(2, r4, r5) SG_MM(3, r6, r7) SG_MM(4, r8, r9) SG_MM(5, r10, r11) SG_MM(6, r12, r13) SG_MM(7, r14, r15)
#undef SG_MM
        }
#pragma unroll
        for (int nf = 0; nf < 8; ++nf) { const u32x2 gw = R.gu[nf];
            u32x2 o; o.x = cvt_pk_bf16(bf_lo(gw.x) * (acc[nf][0] + R.bsv), bf_hi(gw.x) * (acc[nf][1] + R.bsv)); o.y = cvt_pk_bf16(bf_lo(gw.y) * (acc[nf][2] + R.bsv), bf_hi(gw.y) * (acc[nf][3] + R.bsv));
            *(u32x2*)(GUo + (size_t)(t0 + tt) * D + c0 + 16 * nf + 4 * (lane >> 4)) = o; }
        if (next < end) sg_load_b(p, next, tid, R);
        __syncthreads();
    }
}
__device__ __forceinline__ void conv_fixup(KP p, int k, int tid, bf16_t* Ao) {
    const int r = tid >> 8, ch = 4 * (tid & 255); unsigned char* ws = p->ws; const float* cw = p->conv_w;
    const float* HP = (const float*)(ws + WS_HP); const float* HG = (const float*)(ws + WS_HG); const float* TP = (const float*)(ws + WS_TP);
    const f32x4 w0 = *(const f32x4*)(cw + ch), w1 = *(const f32x4*)(cw + D + ch), w2 = *(const f32x4*)(cw + 2 * D + ch);
    const f32x4 ph0 = *(const f32x4*)(HP + ((size_t)k * 2) * D + ch), ph1 = *(const f32x4*)(HP + ((size_t)k * 2 + 1) * D + ch), g = *(const f32x4*)(HG + ((size_t)k * 2 + r) * D + ch);
    f32x4 pt0 = (f32x4){0.f, 0.f, 0.f, 0.f}, pt1 = pt0;
    if (((k * 64) & (SEQ - 1)) != 0) { pt0 = *(const f32x4*)(TP + ((size_t)(k - 1) * 2) * D + ch); pt1 = *(const f32x4*)(TP + ((size_t)(k - 1) * 2 + 1) * D + ch); }
    const f32x4 a = r == 0 ? g * (w2 * ph0 + w1 * pt1 + w0 * pt0) : g * (w2 * ph1 + w1 * ph0 + w0 * pt1);
    u32x2 aw; aw.x = cvt_pk_bf16(a[0], a[1]); aw.y = cvt_pk_bf16(a[2], a[3]);
    *(u32x2*)(Ao + (size_t)(k * 64 + r) * D + ch) = aw;
}

__device__ __forceinline__ void p0_transpose_item(const float* W, int Kd, int Nd, bf16_t* WT, bool map, int n0, int k0, LAS float* scr, int lane) {
    const int nl = lane & 31; const int srcc = map ? win_srccol(n0 + nl) : (n0 + nl);
#pragma unroll 8
    for (int i = 0; i < 32; ++i) { const int kk = 2 * i + (lane >> 5); scr[kk * 33 + nl] = W[(size_t)(k0 + kk) * Nd + srcc]; }
    asm volatile("s_waitcnt lgkmcnt(0)" ::: "memory");
    const int c = lane & 7;
#pragma unroll
    for (int j = 0; j < 4; ++j) { const int n = (lane >> 3) + 8 * j; const LAS float* sp = scr + (8 * c) * 33 + n;
        u32x4 o; o.x = cvt_pk_bf16(sp[0 * 33], sp[1 * 33]); o.y = cvt_pk_bf16(sp[2 * 33], sp[3 * 33]); o.z = cvt_pk_bf16(sp[4 * 33], sp[5 * 33]); o.w = cvt_pk_bf16(sp[6 * 33], sp[7 * 33]);
        *(u32x4*)(WT + (size_t)(n0 + n) * Kd + k0 + 8 * c) = o; }
    asm volatile("s_waitcnt lgkmcnt(0)" ::: "memory");
}
constexpr int PI_IN = 16 * 224, PI_OUT = 32 * 32, PI_XO = 16 * 32, PI_KV = 16 * 64, PI_ALL = PI_IN + PI_OUT + PI_XO + PI_KV;
__device__ __forceinline__ void p0_transpose(KP p, int it, LAS float* scr, int lane) {
    unsigned char* ws = p->ws; int r = it;
    if (r < PI_IN) { p0_transpose_item(p->w_in, D, IN_DIM, (bf16_t*)(ws + WS_WIN), true, (r % 224) * 32, (r / 224) * 64, scr, lane); return; } r -= PI_IN;
    if (r < PI_OUT) { p0_transpose_item(p->w_out, 2 * D, D, (bf16_t*)(ws + WS_WOUT), false, (r % 32) * 32, (r / 32) * 64, scr, lane); return; } r -= PI_OUT;
    if (r < PI_XO) { p0_transpose_item(p->w_xo, D, D, (bf16_t*)(ws + WS_WXO), false, (r % 32) * 32, (r / 32) * 64, scr, lane); return; } r -= PI_XO;
    p0_transpose_item(p->w_kv, D, 2 * D, (bf16_t*)(ws + WS_WKV), false, (r % 64) * 32, (r / 64) * 64, scr, lane);
}
constexpr int NSUB = 32;
__device__ __forceinline__ void sub_arrive(unsigned* word, int wv) {
    asm volatile("s_waitcnt vmcnt(0)" ::: "memory"); __syncthreads();
    if (launder_tid(wv) == 0) { __builtin_amdgcn_fence(__ATOMIC_RELEASE, "agent"); asm volatile("s_waitcnt vmcnt(0)" ::: "memory"); (void)xb_add(word, 1u); }
}
__device__ __forceinline__ void sub_wait(unsigned* word, unsigned target, unsigned* bar, int wv) {
    __syncthreads();
    if (launder_tid(wv) == 0) { XB_SPIN(xb_ld(word) < target, bar); __builtin_amdgcn_fence(__ATOMIC_ACQUIRE, "agent"); asm volatile("s_waitcnt vmcnt(0)" ::: "memory"); }
    __syncthreads();
}
__device__ __forceinline__ void phase0(LAS unsigned char* lds, int wv) {
    KP p = launder_kp(); const int tid = launder_tid(wv), wid = tid >> 6, lane = tid & 63, G = gridDim.x, c = blockIdx.x;
    unsigned char* ws = p->ws;
    { LAS float* scr = (LAS float*)(lds + wid * 8448); for (int it = c * 8 + wid; it < PI_ALL; it += G * 8) p0_transpose(p, it, scr, lane); }
    float* ss = (float*)(ws + WS_SS1);
    for (int i = c * 512 + tid; i < 2 * T; i += G * 512) ss[i] = 0.f;
    { bf16_t* WSb = (bf16_t*)(ws + WS_WS); const float* gws = p->gm_ws;
      for (int i = c * 512 + tid; i < 8 * 128 * 128 / 2; i += G * 512) { const int e = 2 * i, s = e & 127, t = (e >> 7) & 127;
          const float a = (s <= t) ? gws[e] : 0.f, b = (s + 1 <= t) ? gws[e + 1] : 0.f; ((unsigned*)WSb)[i] = cvt_pk_bf16(a, b); } }
    { const float* wq = p->w_q; const float* gx = p->norm_x_g; bf16_t* WqN = (bf16_t*)(ws + WS_WQ);
      for (int idx = c * 512 + tid; idx < D * (D / 16); idx += G * 512) { const int k = idx >> 6, col = (idx & 63) * 16; const float sc = gx[k]; const float* src = wq + (size_t)k * D + col;
          const f32x4 a0 = *(const f32x4*)src, a1 = *(const f32x4*)(src + 4), a2 = *(const f32x4*)(src + 8), a3 = *(const f32x4*)(src + 12);
          u32x4 w0, w1; w0.x = cvt_pk_bf16(a0[0] * sc, a0[1] * sc); w0.y = cvt_pk_bf16(a0[2] * sc, a0[3] * sc); w0.z = cvt_pk_bf16(a1[0] * sc, a1[1] * sc); w0.w = cvt_pk_bf16(a1[2] * sc, a1[3] * sc);
          w1.x = cvt_pk_bf16(a2[0] * sc, a2[1] * sc); w1.y = cvt_pk_bf16(a2[2] * sc, a2[3] * sc); w1.z = cvt_pk_bf16(a3[0] * sc, a3[1] * sc); w1.w = cvt_pk_bf16(a3[2] * sc, a3[3] * sc);
          *(u32x4*)(WqN + (size_t)k * D + col) = w0; *(u32x4*)(WqN + (size_t)k * D + col + 8) = w1; } }
    { const int gw = c * 8 + wid, NGW = G * 8; bf16_t* H = (bf16_t*)(ws + WS_H); bf16_t* MN = (bf16_t*)(ws + WS_MN);
      const float* x = p->x; const float* mem = p->mem; const float* g1 = p->norm_mix_g; const float* g2 = p->norm_mem_g; float* rs0 = (float*)(ws + WS_RS0);
      int r = gw;
      for (; r + NGW < T; r += 2 * NGW) { const float* const xr[2] = {x + (size_t)r * D, x + (size_t)(r + NGW) * D}; bf16_t* const orow[2] = {H + (size_t)r * D, H + (size_t)(r + NGW) * D}; float* const rso[2] = {rs0 + r, rs0 + r + NGW}; rms_rows_to_bf16<2>(xr, g1, orow, lane, rso); }
      for (; r < T; r += NGW) { const float* const xr[1] = {x + (size_t)r * D}; bf16_t* const orow[1] = {H + (size_t)r * D}; float* const rso[1] = {rs0 + r}; rms_rows_to_bf16<1>(xr, g1, orow, lane, rso); }
      for (r = gw; r < NB * MEM; r += NGW) { const float* const xr[1] = {mem + (size_t)r * D}; bf16_t* const orow[1] = {MN + (size_t)r * D}; float* const rso[1] = {nullptr}; rms_rows_to_bf16<1>(xr, g2, orow, lane, rso); } }
}
__device__ __forceinline__ void phase1(LAS unsigned char* lds, int wv) {
    KP p = launder_kp(); unsigned char* ws = p->ws; const int G = gridDim.x, c = blockIdx.x;
    SchedPlain S; S.A0 = (const char*)(ws + WS_H); S.A1 = S.A0; S.Bt = (const char*)(ws + WS_WIN); S.nM = T / 256; S.nN = IN_DIM / 256; S.G = G; S.c = c; S.lda = D; S.ldb = D; S.nt0 = D / 64;
    EpiG1 E; E.A = (bf16_t*)(ws + WS_G); E.GU = (bf16_t*)(ws + WS_GU); E.GV = (bf16_t*)(ws + WS_GV); E.HP = (float*)(ws + WS_HP); E.HG = (float*)(ws + WS_HG); E.TP = (float*)(ws + WS_TP); E.cw = p->conv_w;
    Gemm g; g.lda = D; g.ldb = D; g.K = D; g.nt0 = D / 64;
    pg8::gemm_phase<EpiG1, SchedPlain, true>(lds, g, S, E, wv);
}
__device__ __forceinline__ Unit wp_unit(unsigned char* ws, int bh, int nt) { const int b = bh >> 2, h = bh & 3; Unit u; u.pm = 0; u.pn = nt; u.z = bh;
    u.a0 = (const char*)(ws + WS_KB) + ((size_t)(b * MEM) * 2 * D + h * HD) * 2; u.a1 = u.a0 - (size_t)(HD / 64) * 128; u.b = (const char*)(ws + WS_WQ) + ((size_t)(nt * 256) * D + h * HD) * 2; return u; }
__device__ __forceinline__ Unit vw_unit(unsigned char* ws, int bh, int mt) { const int b = bh >> 2, h = bh & 3; Unit u; u.pm = mt; u.pn = 0; u.z = bh;
    u.a0 = (const char*)(ws + WS_WXO) + ((size_t)(mt * 256) * D + h * HD) * 2; u.a1 = u.a0 - (size_t)(HD / 64) * 128; u.b = (const char*)(ws + WS_KB) + ((size_t)(b * MEM) * 2 * D + D + h * HD) * 2; return u; }
__device__ __forceinline__ void run_wp(LAS unsigned char* lds, int wv, int ui) { KP p = launder_kp(); unsigned char* ws = p->ws; const int bh = ui >> 2;
    SchedOne S; S.u0 = wp_unit(ws, bh, ui & 3); EpiBf E; E.O = (bf16_t*)(ws + WS_WP) + (size_t)bh * 256 * D; E.ld = D;
    Gemm g; g.lda = 2 * D; g.ldb = D; g.K = HD; g.nt0 = HD / 64; pg8::gemm_phase<EpiBf, SchedOne, true>(lds, g, S, E, wv); __syncthreads(); }
__device__ __forceinline__ void run_vw(LAS unsigned char* lds, int wv, int ui) { KP p = launder_kp(); unsigned char* ws = p->ws; const int bh = ui >> 2, b = bh >> 2, h = bh & 3;
    SchedOne S; S.u0 = vw_unit(ws, bh, ui & 3); EpiBf E; E.O = (bf16_t*)(ws + WS_VW) + (size_t)b * D * D + h * HD; E.ld = D;
    Gemm g; g.lda = D; g.ldb = 2 * D; g.K = HD; g.nt0 = HD / 64; pg8::gemm_phase<EpiBf, SchedOne, true>(lds, g, S, E, wv); __syncthreads(); }
__device__ __forceinline__ void phase2(LAS unsigned char* lds, int wv, bool dry, int mask) {
    const int G = gridDim.x, c = blockIdx.x;
    if (mask & 4) { KP p = launder_kp(); const int tid = launder_tid(wv); bf16_t* Go = (bf16_t*)(p->ws + (dry ? (size_t)220 * MB : WS_G));
      for (int it = c; it < T / 64; it += G) conv_fixup(p, it, tid, Go); }
    unsigned* subw = (unsigned*)(launder_kp()->ws + WS_SUB) + (dry ? 64 : 0); unsigned* bar = (unsigned*)(launder_kp()->ws + WS_BAR);
    if (c < NSUB) {
        if (mask & 1) { { KP p = launder_kp(); unsigned char* ws = p->ws;
          SchedPlain S; S.A0 = (const char*)(ws + WS_MN); S.A1 = S.A0; S.Bt = (const char*)(ws + WS_WKV); S.nM = NB * MEM / 256; S.nN = 2 * D / 256; S.G = NSUB; S.c = c; S.lda = D; S.ldb = D; S.nt0 = D / 64;
          EpiBf E; E.O = (bf16_t*)(ws + WS_KB); E.ld = 2 * D;
          Gemm g; g.lda = D; g.ldb = D; g.K = D; g.nt0 = D / 64;
          pg8::gemm_phase<EpiBf, SchedPlain, true>(lds, g, S, E, wv); }
          sub_arrive(subw, wv); sub_wait(subw, NSUB, bar, wv); run_vw(lds, wv, c); }
    } else if (c < NSUB + 64) {
        if (mask & 2) { KP p = launder_kp(); const int tid = launder_tid(wv); bf16_t* GUo = (bf16_t*)(p->ws + (dry ? (size_t)220 * MB : WS_GU));
          sg_items(p, lds, c - NSUB, 96, 384, tid, GUo); }
        if (mask & 1) { sub_wait(subw, NSUB, bar, wv); run_wp(lds, wv, c - NSUB); }
    } else if (c < NSUB + 96) {
        if (mask & 2) { KP p = launder_kp(); const int tid = launder_tid(wv); bf16_t* GUo = (bf16_t*)(p->ws + (dry ? (size_t)220 * MB : WS_GU));
          sg_items(p, lds, c - NSUB, 96, 384, tid, GUo); }
        if (mask & 1) { sub_wait(subw, NSUB, bar, wv); run_vw(lds, wv, c - NSUB - 64 + 32); }
    } else {
        if (mask & 2) { KP p = launder_kp(); const int tid = launder_tid(wv); bf16_t* GUo = (bf16_t*)(p->ws + (dry ? (size_t)220 * MB : WS_GU));
          sg_items(p, lds, 384 + (c - 128), 128, 1024, tid, GUo); }
    }
}
__device__ __forceinline__ void phase3(LAS unsigned char* lds, int wv, bool dry) {
    KP p = launder_kp(); unsigned char* ws = p->ws; const int G = gridDim.x, c = blockIdx.x;
    SchedPlain S; S.A0 = (const char*)(ws + WS_G); S.A1 = (const char*)(ws + WS_GU); S.Bt = (const char*)(ws + WS_WOUT); S.nM = T / 256; S.nN = D / 256; S.G = G; S.c = c; S.lda = D; S.ldb = 2 * D; S.nt0 = D / 64;
    EpiX1 E; E.hb = (bf16_t*)(ws + WS_H); E.rs0 = (const float*)(ws + WS_RS0); E.g = p->norm_mix_g; E.rowss = (float*)(ws + WS_SS1);
    Gemm g; g.lda = D; g.ldb = 2 * D; g.K = 2 * D; g.nt0 = D / 64;
    pg8::gemm_phase<EpiX1, SchedPlain, true>(lds, g, S, E, wv);
}
__device__ __forceinline__ void local_fence() {
    asm volatile("s_waitcnt vmcnt(0)" ::: "memory"); __syncthreads();
    __builtin_amdgcn_fence(__ATOMIC_ACQUIRE, "agent"); asm volatile("s_waitcnt vmcnt(0)" ::: "memory"); __syncthreads();
}
__device__ __forceinline__ void phase456(LAS unsigned char* lds, int wv) {
    const int G = gridDim.x, c = blockIdx.x;
    for (int i = 0;; ++i) {
        int pm, pn; if (!pg8::static_order(T / 256, D / 256, G, c, i, pm, pn)) break;
        const int b = pm >> 4, h = pn, bh = b * 4 + h;
        KP p = launder_kp(); unsigned char* ws = p->ws;
        SchedOne S; S.u0.pm = pm; S.u0.pn = pn; S.u0.z = bh;
        S.u0.a0 = (const char*)(ws + WS_H) + (size_t)pm * 256 * D * 2; S.u0.a1 = S.u0.a0 - (size_t)(D / 64) * 128;
        S.u0.b = (const char*)(ws + WS_WP) + (size_t)bh * 256 * D * 2;
        EpiS E; E.Pb = (bf16_t*)(ws + WS_GV); E.rowss = (const float*)(ws + WS_SS1); E.grow0 = pm * 256; E.hcol = h * HD;
        Gemm g; g.lda = D; g.ldb = D; g.K = D; g.nt0 = D / 64;
        pg8::gemm_phase<EpiS, SchedOne, false>(lds, g, S, E, wv);
    }
}
__device__ __forceinline__ void phase7(LAS unsigned char* lds, int wv, bool dry) {
    KP p = launder_kp(); unsigned char* ws = p->ws; const int G = gridDim.x, c = blockIdx.x;
    int pm, pn; pg8::static_order(T / 256, D / 256, G, c, 0, pm, pn);
    SchedOne S; S.u0.pm = pm; S.u0.pn = pn; S.u0.z = 0;
    S.u0.a0 = (const char*)(ws + WS_GV) + (size_t)pm * 256 * D * 2; S.u0.a1 = S.u0.a0 - (size_t)(D / 64) * 128; S.u0.b = (const char*)(ws + WS_VW) + ((size_t)(pm >> 4) * D + pn * 256) * D * 2;
    EpiFinal E; E.xb = (const bf16_t*)(ws + WS_H); E.out = dry ? (float*)(ws + WS_G) : p->out; E.gf = p->norm_final_g; E.slots = (float*)(ws + WS_SLOT) + (dry ? 65536 : 0);
    E.cnt = (unsigned*)(ws + WS_CNT) + (dry ? 32 : 0); E.bar = (unsigned*)(ws + WS_BAR);
    Gemm g; g.lda = D; g.ldb = D; g.K = D; g.nt0 = D / 64;
    pg8::gemm_phase<EpiFinal, SchedOne, false>(lds, g, S, E, wv);
}

__global__ __launch_bounds__(512, 2) void fwd_megakernel(Params p_unused) {
    extern __shared__ __attribute__((aligned(16))) unsigned char shm[];
    LAS unsigned char* lds = (LAS unsigned char*)shm;
    volatile LAS unsigned* st = (volatile LAS unsigned*)(lds + pg8::STAGE_BYTES);
    const int wv = __builtin_amdgcn_readfirstlane((int)(threadIdx.x >> 6));
    if (launder_tid(wv) == 0) { st[0] = 0u; st[1] = 0u; (void)xb_add((unsigned*)(launder_kp()->ws + WS_BAR) + XB_XCNT(xb_xcc_id()), 1u); }
    __syncthreads();
    if (gridDim.y == 12345u) cg::this_grid().sync();
#define GRID_SYNC() xcd_barrier(st, wv)
    for (int r = 0; r < REP_P0; ++r) { phase0(lds, wv); GRID_SYNC(); }
    for (int r = 0; r < REP_P1; ++r) { phase1(lds, wv); GRID_SYNC(); }
    for (int r = 0; r < EXTRA_SYNCS; ++r) GRID_SYNC();
    if (PROBE_P2_MASK) { phase2(lds, wv, true, PROBE_P2_MASK); GRID_SYNC(); }
    phase2(lds, wv, false, 7); GRID_SYNC();
    for (int r = REP_P3 - 1; r >= 0; --r) { phase3(lds, wv, r > 0); GRID_SYNC(); }
    phase456(lds, wv); GRID_SYNC();
    for (int r = REP_P7 - 1; r >= 0; --r) { phase7(lds, wv, r > 0); if (r > 0) GRID_SYNC(); }
}

extern "C" void kernel_launch(void* const* d_in, const int* in_sizes, int n_in, void* d_out, int out_size, void* d_ws, size_t ws_size, hipStream_t stream) {
    constexpr size_t kDynLds = pg8::STAGE_BYTES + 16;
    static int grid_blocks = 0;
    if (!grid_blocks) {
        if (n_in != 16 || in_sizes[0] != T * D || out_size != T * D || ws_size < WS_END) { fprintf(stderr, "kernel_launch: unexpected shapes (n_in %d, in0 %d, out %d, ws %zu)\n", n_in, n_in > 0 ? in_sizes[0] : -1, out_size, ws_size); grid_blocks = -1; return; }
        int dev = 0, cus = 0, per_cu = 0;
        hipGetDevice(&dev);
        hipDeviceGetAttribute(&cus, hipDeviceAttributeMultiprocessorCount, dev);
        if (hipFuncSetAttribute((const void*)fwd_megakernel, hipFuncAttributeMaxDynamicSharedMemorySize, (int)kDynLds) != hipSuccess) { fprintf(stderr, "kernel_launch: hipFuncSetAttribute failed\n"); }
        hipOccupancyMaxActiveBlocksPerMultiprocessor(&per_cu, (const void*)fwd_megakernel, 512, kDynLds);
        if (per_cu < 1) { fprintf(stderr, "kernel_launch: occupancy query says %d blocks per CU\n", per_cu); per_cu = 1; }
        (void)hipGetLastError();
        if (cus != 256) { fprintf(stderr, "kernel_launch: built for a 256-CU device (one 512-thread workgroup per CU, one 256x256 unit per workgroup in the fused phases); got %d CUs\n", cus); grid_blocks = -1; return; }
        grid_blocks = cus;
    }
    if (grid_blocks < 0) return;
    if (hipMemsetAsync((char*)d_ws + WS_BAR, 0, 49152, stream) != hipSuccess) { fprintf(stderr, "kernel_launch: memset of the barrier words failed\n"); return; }
    Params p{};
    const float** pp = (const float**)&p;
    for (int i = 0; i < 16; ++i) pp[i] = (const float*)d_in[i];
    p.out = (float*)d_out; p.ws = (unsigned char*)d_ws;
    void* args[] = {&p};
    hipError_t e = hipLaunchCooperativeKernel((const void*)fwd_megakernel, dim3(grid_blocks), dim3(512), args, kDynLds, stream);
    if (e != hipSuccess) fprintf(stderr, "cooperative launch failed: %s (grid %d)\n", hipGetErrorString(e), grid_blocks);
}
```
